# Optimizing an MI355X kernel written in HIP

```python
import math
import jax, jax.numpy as jnp
from jax import lax
import numpy as np

D_MODEL = 1024
BATCH = 8
SEQ = 4096
DEPTH = 4

CHUNK = 64
Q_BLOCK = 128
EPS = 1e-6
MIX_WIDTH = D_MODEL
ATT_WIDTH = MIX_WIDTH // 2
CONV_WIDTH = MIX_WIDTH // 4
SSM_WIDTH = MIX_WIDTH - ATT_WIDTH - CONV_WIDTH
ATT_HEAD_DIM = 64
ATT_V_DIM = 2 * ATT_HEAD_DIM
N_ATT_HEADS = ATT_WIDTH // ATT_V_DIM
QK_WIDTH = N_ATT_HEADS * 2 * ATT_HEAD_DIM
CONV_KERNEL = 31
SSM_GROUP = 16
N_SSM_GROUPS = SSM_WIDTH // SSM_GROUP
SSM_STATE = 64
D_FF = 4 * D_MODEL
PLE_DIM = 256
IN_WIDTH = 2 * QK_WIDTH + ATT_WIDTH + 2 * CONV_WIDTH + SSM_WIDTH
SPLITS = (QK_WIDTH, 2 * QK_WIDTH, 2 * QK_WIDTH + ATT_WIDTH, 2 * QK_WIDTH + ATT_WIDTH + 2 * CONV_WIDTH)

kernel_name = "hybrid_diffattn_conformer_s5_block"


def rms_norm(x, g):
    x32 = x.astype(jnp.float32)
    y = x32 * lax.rsqrt(jnp.mean(jnp.square(x32), axis=-1, keepdims=True) + EPS)
    return (y * g.astype(jnp.float32)).astype(x.dtype)


def layer_norm(x, g, b):
    x32 = x.astype(jnp.float32)
    mu = jnp.mean(x32, axis=-1, keepdims=True)
    var = jnp.mean(jnp.square(x32 - mu), axis=-1, keepdims=True)
    y = (x32 - mu) * lax.rsqrt(var + EPS)
    return (y * g.astype(jnp.float32) + b.astype(jnp.float32)).astype(x.dtype)


def diff_attention(q, k, v, q_gain, k_gain, lam, out_gain, lam_init):
    bsz, seq = q.shape[0], q.shape[1]
    q = rms_norm(q, q_gain)
    k = rms_norm(k, k_gain)
    n_blk = seq // Q_BLOCK
    qb = q.reshape(bsz, n_blk, Q_BLOCK, N_ATT_HEADS, 2, ATT_HEAD_DIM).swapaxes(0, 1)
    kpos = jnp.arange(seq)
    kchunk = kpos // CHUNK
    slopes = 2.0 ** (-8.0 * jnp.arange(1, N_ATT_HEADS + 1, dtype=jnp.float32) / N_ATT_HEADS)
    scale = ATT_HEAD_DIM ** -0.5

    def block(args):
        qi, bi = args
        qpos = bi * Q_BLOCK + jnp.arange(Q_BLOCK)
        s = jnp.einsum('bqhcd,bkhcd->bhcqk', qi, k).astype(jnp.float32) * scale
        dist = jnp.abs(qpos[:, None] - kpos[None, :]).astype(jnp.float32)
        bias = -slopes[:, None, None, None] * dist[None, None]
        allowed = kchunk[None, :] <= (qpos // CHUNK)[:, None]
        s = jnp.where(allowed, s + bias, -1e30)
        pr = jax.nn.softmax(s, axis=-1)
        a = pr[:, :, 0] - lam * pr[:, :, 1]
        return jnp.einsum('bhqk,bkhd->bqhd', a.astype(v.dtype), v)

    o = lax.map(block, (qb, jnp.arange(n_blk)))
    o = o.swapaxes(0, 1).reshape(bsz, seq, N_ATT_HEADS, ATT_V_DIM)
    o = rms_norm(o, out_gain) * (1.0 - lam_init)
    return o.reshape(bsz, seq, N_ATT_HEADS * ATT_V_DIM)


def conformer_conv(u, w, b, ln_g, ln_b):
    a, gate = jnp.split(u, 2, axis=-1)
    hcv = a * jax.nn.sigmoid(gate)
    hcv = lax.conv_general_dilated(
        hcv, w[:, None, :], window_strides=(1,), padding=[(CONV_KERNEL - 1, 0)],
        dimension_numbers=('NWC', 'WIO', 'NWC'), feature_group_count=CONV_WIDTH) + b
    return jax.nn.silu(layer_norm(hcv, ln_g, ln_b))


def _ssm_combine(left, right):
    a_l, b_l = left
    a_r, b_r = right
    return a_l * a_r, a_r * b_l + b_r


def s5_ssm(u, a_re, a_im, log_dt, b_re, b_im, c_re, c_im, d_skip, glu_w, glu_b):
    bsz, seq = u.shape[0], u.shape[1]
    f32 = jnp.float32
    ug = u.reshape(bsz, seq, N_SSM_GROUPS, SSM_GROUP).astype(f32)
    lam = lax.complex(a_re.astype(f32), a_im.astype(f32))
    dt = jnp.exp(log_dt.astype(f32))[:, None]
    abar = jnp.exp(lam * dt)
    bmat = lax.complex(b_re.astype(f32), b_im.astype(f32))
    bbar = ((abar - 1.0) / lam)[..., None] * bmat
    bu = lax.complex(jnp.einsum('gpc,bsgc->bsgp', jnp.real(bbar), ug),
                     jnp.einsum('gpc,bsgc->bsgp', jnp.imag(bbar), ug))
    a_seq = jnp.broadcast_to(abar[None, None], (1, seq, N_SSM_GROUPS, SSM_STATE))
    _, xs = lax.associative_scan(_ssm_combine, (a_seq, bu), axis=1)
    y = (jnp.einsum('gcp,bsgp->bsgc', c_re.astype(f32), jnp.real(xs))
         - jnp.einsum('gcp,bsgp->bsgc', c_im.astype(f32), jnp.imag(xs))
         + d_skip.astype(f32) * ug)
    y = jax.nn.gelu(y.reshape(bsz, seq, SSM_WIDTH)).astype(u.dtype)
    return y * jax.nn.sigmoid(y @ glu_w + glu_b)


def setup_inputs(seed: int = 0) -> dict:
    key = jax.random.key(seed)
    ks = iter(jax.random.split(key, 40))
    L = DEPTH
    f32 = jnp.float32

    def nrm(shape, scale):
        return jax.random.normal(next(ks), shape, f32) * scale

    def gain(shape):
        return 1.0 + 0.05 * jax.random.normal(next(ks), shape, f32)

    G, P, C = N_SSM_GROUPS, SSM_STATE, SSM_GROUP
    return {
        "x": nrm((BATCH, SEQ, D_MODEL), 1.0),
        "p": nrm((DEPTH, BATCH, SEQ, PLE_DIM), 1.0),
        "mix_norm": gain((L, D_MODEL)),
        "w_in": nrm((L, D_MODEL, IN_WIDTH), D_MODEL ** -0.5),
        "q_norm": gain((L, ATT_HEAD_DIM)),
        "k_norm": gain((L, ATT_HEAD_DIM)),
        "lam_q1": nrm((L, ATT_HEAD_DIM), 0.1),
        "lam_k1": nrm((L, ATT_HEAD_DIM), 0.1),
        "lam_q2": nrm((L, ATT_HEAD_DIM), 0.1),
        "lam_k2": nrm((L, ATT_HEAD_DIM), 0.1),
        "att_out_norm": gain((L, ATT_V_DIM)),
        "conv_w": nrm((L, CONV_KERNEL, CONV_WIDTH), CONV_KERNEL ** -0.5),
        "conv_b": nrm((L, CONV_WIDTH), 0.02),
        "conv_ln_g": gain((L, CONV_WIDTH)),
        "conv_ln_b": nrm((L, CONV_WIDTH), 0.02),
        "ssm_a_re": -0.5 + nrm((L, G, P), 0.01),
        "ssm_a_im": math.pi * jnp.arange(P, dtype=f32)[None, None, :] + nrm((L, G, P), 0.01),
        "ssm_log_dt": jax.random.uniform(next(ks), (L, G), f32, math.log(1e-3), math.log(1e-1)),
        "ssm_b_re": nrm((L, G, P, C), (2 * C) ** -0.5),
        "ssm_b_im": nrm((L, G, P, C), (2 * C) ** -0.5),
        "ssm_c_re": nrm((L, G, C, P), P ** -0.5),
        "ssm_c_im": nrm((L, G, C, P), P ** -0.5),
        "ssm_d": nrm((L, G, C), 1.0),
        "ssm_glu_w": nrm((L, SSM_WIDTH, SSM_WIDTH), SSM_WIDTH ** -0.5),
        "ssm_glu_b": nrm((L, SSM_WIDTH), 0.02),
        "w_out": nrm((L, MIX_WIDTH, D_MODEL), MIX_WIDTH ** -0.5),
        "mlp_norm": gain((L, D_MODEL)),
        "w_ff1": nrm((L, D_MODEL, D_FF), D_MODEL ** -0.5),
        "w_ff2": nrm((L, D_FF, D_MODEL), D_FF ** -0.5),
        "ple_norm": gain((L, D_MODEL)),
        "w_ple_gate": nrm((L, D_MODEL, D_MODEL), D_MODEL ** -0.5),
        "w_ple_proj": nrm((L, PLE_DIM, D_MODEL), PLE_DIM ** -0.5),
    }


def reference(x, p, mix_norm, w_in, q_norm, k_norm, lam_q1, lam_k1, lam_q2, lam_k2,
              att_out_norm, conv_w, conv_b, conv_ln_g, conv_ln_b, ssm_a_re, ssm_a_im,
              ssm_log_dt, ssm_b_re, ssm_b_im, ssm_c_re, ssm_c_im, ssm_d, ssm_glu_w,
              ssm_glu_b, w_out, mlp_norm, w_ff1, w_ff2, ple_norm, w_ple_gate, w_ple_proj):
    bsz, seq, _ = x.shape
    h = x
    for i in range(DEPTH):
        lam_init = 0.8 - 0.6 * math.exp(-0.3 * i)
        n = rms_norm(h, mix_norm[i])
        z = n @ w_in[i]
        zq, zk, zv, zc, zs = jnp.split(z, SPLITS, axis=-1)
        q = zq.reshape(bsz, seq, N_ATT_HEADS, 2, ATT_HEAD_DIM)
        k = zk.reshape(bsz, seq, N_ATT_HEADS, 2, ATT_HEAD_DIM)
        v = zv.reshape(bsz, seq, N_ATT_HEADS, ATT_V_DIM)
        lam = (jnp.exp(jnp.sum(lam_q1[i].astype(jnp.float32) * lam_k1[i].astype(jnp.float32)))
               - jnp.exp(jnp.sum(lam_q2[i].astype(jnp.float32) * lam_k2[i].astype(jnp.float32)))
               + lam_init)
        att = diff_attention(q, k, v, q_norm[i], k_norm[i], lam, att_out_norm[i], lam_init)
        cnv = conformer_conv(zc, conv_w[i], conv_b[i], conv_ln_g[i], conv_ln_b[i])
        ssm = s5_ssm(zs, ssm_a_re[i], ssm_a_im[i], ssm_log_dt[i], ssm_b_re[i], ssm_b_im[i],
                     ssm_c_re[i], ssm_c_im[i], ssm_d[i], ssm_glu_w[i], ssm_glu_b[i])
        mixed = jnp.concatenate([att, cnv, ssm], axis=-1)
        h = h + mixed @ w_out[i]
        n2 = rms_norm(h, mlp_norm[i])
        h = h + jnp.square(jax.nn.relu(n2 @ w_ff1[i])) @ w_ff2[i]
        gate = jax.nn.sigmoid(rms_norm(h, ple_norm[i]) @ w_ple_gate[i])
        h = h + gate * (p[i] @ w_ple_proj[i])
    return h
```

```cpp
#include <hip/hip_runtime.h>
#include <hip/hip_cooperative_groups.h>
#include <cstdio>
#include <cstdint>
namespace cg = cooperative_groups;
namespace pg8 {
#define PG8_LAS __attribute__((address_space(3)))
typedef unsigned short bf16_t;
typedef short bf16x8 __attribute__((ext_vector_type(8)));
typedef float f32x4 __attribute__((ext_vector_type(4)));
typedef unsigned u32x4 __attribute__((ext_vector_type(4)));
constexpr int BM = 256, BK = 64, HALF = 128, HTB = HALF * BK * 2  , STAGE_BYTES = 8 * HTB, NXCD = 8, WGM = 8;

__host__ __device__ __forceinline__ int lds_byte(int r, int c) { const int st = (r >> 4) * 2 + (c >> 5), rr = r & 15, cc = c & 31, ob = rr * 64 + cc * 2; return st * 1024 + (ob ^ (((ob >> 9) & 1) << 5)); }
__host__ __device__ __forceinline__ void stage_rc(int b, int& R, int& C) { const int st = b / 1024, sb = b % 1024, swz = sb ^ (((sb >> 9) & 1) << 5); R = (st >> 1) * 16 + swz / 64; C = (st & 1) * 32 + (swz % 64) / 2; }
__host__ __device__ __forceinline__ int perm32(int rho) { const int n = rho >> 4, i = rho & 15; return 8 * (i >> 2) + 4 * n + (i & 3); }

struct Unit { int pm, pn; };
struct Gemm { const bf16_t* A; const bf16_t* Bt; int M, N, K; };

struct StaticOrder {
    int nM, nN, nwg, G, c;
    __host__ __device__ void init(int M, int N, int G_, int c_) { nM = M / BM; nN = N / BM; nwg = nM * nN; G = G_; c = c_; }
    __host__ __device__ bool next(int i, Unit& u) const {
        const long L = (long)i * G + c; if (L >= nwg) return false;
        int wgid = (int)L; { const int q = nwg / NXCD, r = nwg % NXCD, xcd = wgid % NXCD, off = wgid / NXCD; wgid = (xcd < r ? xcd * (q + 1) : r * (q + 1) + (xcd - r) * q) + off; }
        const int nig = WGM * nN, gid = wgid / nig, fm = gid * WGM, gsz = (nM - fm) < WGM ? (nM - fm) : WGM;
        u.pm = fm + ((wgid % nig) % gsz); u.pn = (wgid % nig) / gsz; return true;
    }
    __device__ __forceinline__ void a_ready(const Unit&) const {}
    __device__ __forceinline__ void done(const Unit&) const {}
};

__device__ __forceinline__ unsigned cvt_pk_bf16(float lo, float hi) { unsigned r; asm volatile("v_cvt_pk_bf16_f32 %0, %1, %2" : "=v"(r) : "v"(lo), "v"(hi)); return r; }
typedef unsigned u32x2v __attribute__((ext_vector_type(2)));
__device__ __forceinline__ float bf_lo(unsigned w) { return __uint_as_float(w << 16); }
__device__ __forceinline__ float bf_hi(unsigned w) { return __uint_as_float(w & 0xffff0000u); }
__device__ __forceinline__ float sigmoidf_(float x) { return __builtin_amdgcn_rcpf(1.0f + __expf(-x)); }
__device__ __forceinline__ float row_rstd(const float* ssq, int row) {
    const f32x4* p = (const f32x4*)(ssq + (size_t)row * 16);
    const f32x4 a = p[0], b = p[1], c = p[2], d = p[3];
    const float s = ((a[0] + a[1]) + (a[2] + a[3])) + ((b[0] + b[1]) + (b[2] + b[3])) + ((c[0] + c[1]) + (c[2] + c[3])) + ((d[0] + d[1]) + (d[2] + d[3]));
    return __builtin_amdgcn_rsqf(s * (1.0f / 1024.0f) + 1e-6f);
}
struct EpiOut {
    static constexpr bool PERM = true, AFTER_DRAIN = false;
    bf16_t* O; int ldc; const float* ssq; int act; const float* qg; const float* kg;
    __device__ __forceinline__ void operator()(const f32x4 (&acc)[2][2][4][2], const Unit& u, int wr, int wc, int fr, int fq) const {
        const int row0 = u.pm * BM + wr * 64 + fr; const bool win = qg != nullptr; const bool qkn = win && u.pn < 4;
        const int colb0 = win ? u.pn * BM + wc * 64 + 8 * fq : u.pn * BM + wc * 32 + 8 * fq; const int bjs = win ? 32 : HALF;
        f32x4 gn[2][2];
        if (qkn) { const float* gp = (u.pn < 2 ? qg : kg) + 8 * fq;
#pragma unroll
            for (int bj = 0; bj < 2; ++bj) { gn[bj][0] = *(const f32x4*)(gp + 32 * bj); gn[bj][1] = *(const f32x4*)(gp + 32 * bj + 4); } }
        f32x4 pr[2][4];
        if (ssq) {
#pragma unroll
            for (int ai = 0; ai < 2; ++ai)
#pragma unroll
                for (int m = 0; m < 4; ++m) pr[ai][m] = *(const f32x4*)(ssq + (size_t)(row0 + ai * HALF + m * 16) * 16 + 4 * fq); }
#pragma unroll
        for (int ai = 0; ai < 2; ++ai)
#pragma unroll
            for (int m = 0; m < 4; ++m) { const int row = row0 + ai * HALF + m * 16; float sc = 1.0f;
                if (ssq) { float t = (pr[ai][m][0] + pr[ai][m][1]) + (pr[ai][m][2] + pr[ai][m][3]); t += __shfl_xor(t, 16); t += __shfl_xor(t, 32); sc = __builtin_amdgcn_rsqf(t * (1.0f / 1024.0f) + 1e-6f); }
                bf16_t* rowp = O + (size_t)row * ldc + colb0;
                f32x4 v[2][2];
#pragma unroll
                for (int bj = 0; bj < 2; ++bj) { v[bj][0] = acc[ai][bj][m][0] * sc; v[bj][1] = acc[ai][bj][m][1] * sc; }
                if (qkn) { float s = 0.f;
#pragma unroll
                    for (int bj = 0; bj < 2; ++bj)
#pragma unroll
                        for (int n = 0; n < 2; ++n) s += (v[bj][n][0] * v[bj][n][0] + v[bj][n][1] * v[bj][n][1]) + (v[bj][n][2] * v[bj][n][2] + v[bj][n][3] * v[bj][n][3]);
                    s += __shfl_xor(s, 16); s += __shfl_xor(s, 32);
                    const float rs = __builtin_amdgcn_rsqf(s * (1.0f / 64.0f) + 1e-6f);
#pragma unroll
                    for (int bj = 0; bj < 2; ++bj) { v[bj][0] = v[bj][0] * rs * gn[bj][0]; v[bj][1] = v[bj][1] * rs * gn[bj][1]; } }
#pragma unroll
                for (int bj = 0; bj < 2; ++bj) { f32x4 v0 = v[bj][0], v1 = v[bj][1];
                    if (act == 2) {
#pragma unroll
                        for (int e = 0; e < 4; ++e) { const float a = fmaxf(v0[e], 0.f), b = fmaxf(v1[e], 0.f); v0[e] = a * a; v1[e] = b * b; } }
                    u32x4 w; w.x = cvt_pk_bf16(v0[0], v0[1]); w.y = cvt_pk_bf16(v0[2], v0[3]); w.z = cvt_pk_bf16(v1[0], v1[1]); w.w = cvt_pk_bf16(v1[2], v1[3]);
                    *(u32x4*)(rowp + bj * bjs) = w; } }
    }
};
struct EpiResid {
    static constexpr bool PERM = true, AFTER_DRAIN = false;
    const float* hin; float* h; bf16_t* xn; float* ssq_out; const float* ssq_in; const bf16_t* pp; int gated;
    __device__ __forceinline__ void operator()(const f32x4 (&acc)[2][2][4][2], const Unit& u, int wr, int wc, int fr, int fq) const {
        const int row0 = u.pm * BM + wr * 64 + fr; const int col0 = u.pn * BM + wc * 32 + 8 * fq;
        f32x4 hn[2][2]; u32x4 pn_[2]; f32x4 qn_ = (f32x4){0.f, 0.f, 0.f, 0.f};
#define PG8_RES_LOAD(IT) do { const size_t roff_ = (size_t)(row0 + ((IT) >> 2) * HALF + ((IT) & 3) * 16) * 1024 + col0; \
        _Pragma("unroll") for (int bj = 0; bj < 2; ++bj) { hn[bj][0] = *(const f32x4*)(hin + roff_ + bj * HALF); hn[bj][1] = *(const f32x4*)(hin + roff_ + bj * HALF + 4); \
            if (gated) pn_[bj] = *(const u32x4*)(pp + roff_ + bj * HALF); } \
        if (gated) qn_ = *(const f32x4*)(ssq_in + (size_t)(row0 + ((IT) >> 2) * HALF + ((IT) & 3) * 16) * 16 + 4 * fq); } while (0)
        PG8_RES_LOAD(0);
#pragma unroll
        for (int it = 0; it < 8; ++it) { const int ai = it >> 2, m = it & 3; const int row = row0 + ai * HALF + m * 16;
            f32x4 hc[2][2]; u32x4 pc[2];
#pragma unroll
            for (int bj = 0; bj < 2; ++bj) { hc[bj][0] = hn[bj][0]; hc[bj][1] = hn[bj][1]; pc[bj] = pn_[bj]; }
            const f32x4 qc = qn_;
            if (it < 7) PG8_RES_LOAD(it + 1);
            asm volatile("" ::: "memory");
            float rs = 1.0f;
            if (gated) { float t = (qc[0] + qc[1]) + (qc[2] + qc[3]); t += __shfl_xor(t, 16); t += __shfl_xor(t, 32); rs = __builtin_amdgcn_rsqf(t * (1.0f / 1024.0f) + 1e-6f); }
            float s = 0.f; const size_t roff = (size_t)row * 1024 + col0;
#pragma unroll
            for (int bj = 0; bj < 2; ++bj) { const size_t off = roff + bj * HALF;
                f32x4 a0 = acc[ai][bj][m][0], a1 = acc[ai][bj][m][1];
                if (gated) { const u32x4 pw = pc[bj];
                    a0[0] = sigmoidf_(a0[0] * rs) * bf_lo(pw.x); a0[1] = sigmoidf_(a0[1] * rs) * bf_hi(pw.x); a0[2] = sigmoidf_(a0[2] * rs) * bf_lo(pw.y); a0[3] = sigmoidf_(a0[3] * rs) * bf_hi(pw.y);
                    a1[0] = sigmoidf_(a1[0] * rs) * bf_lo(pw.z); a1[1] = sigmoidf_(a1[1] * rs) * bf_hi(pw.z); a1[2] = sigmoidf_(a1[2] * rs) * bf_lo(pw.w); a1[3] = sigmoidf_(a1[3] * rs) * bf_hi(pw.w); }
                const f32x4 h0 = hc[bj][0] + a0, h1 = hc[bj][1] + a1;
                *(f32x4*)(h + off) = h0; *(f32x4*)(h + off + 4) = h1;
                s += ((h0[0] * h0[0] + h0[1] * h0[1]) + (h0[2] * h0[2] + h0[3] * h0[3])) + ((h1[0] * h1[0] + h1[1] * h1[1]) + (h1[2] * h1[2] + h1[3] * h1[3]));
                u32x4 w; w.x = cvt_pk_bf16(h0[0], h0[1]); w.y = cvt_pk_bf16(h0[2], h0[3]); w.z = cvt_pk_bf16(h1[0], h1[1]); w.w = cvt_pk_bf16(h1[2], h1[3]);
                *(u32x4*)(xn + off) = w; }
            s += __shfl_xor(s, 16); s += __shfl_xor(s, 32);
            if (fq == 0) ssq_out[(size_t)row * 16 + u.pn * 4 + wc] = s; }
#undef PG8_RES_LOAD
    }
};
struct EpiGlu {
    static constexpr bool PERM = true, AFTER_DRAIN = false;
    const bf16_t* yg; const float* bias; bf16_t* mix;
    __device__ __forceinline__ void operator()(const f32x4 (&acc)[2][2][4][2], const Unit& u, int wr, int wc, int fr, int fq) const {
        const int row0 = u.pm * BM + wr * 64 + fr; const int col0 = u.pn * BM + wc * 32 + 8 * fq;
#pragma unroll
        for (int bj = 0; bj < 2; ++bj) { const int c = col0 + bj * HALF;
            const f32x4 b0 = *(const f32x4*)(bias + c), b1 = *(const f32x4*)(bias + c + 4);
#pragma unroll
            for (int ai = 0; ai < 2; ++ai)
#pragma unroll
                for (int m = 0; m < 4; ++m) { const int row = row0 + ai * HALF + m * 16; asm volatile("" ::: "memory");
                    const u32x4 yw = *(const u32x4*)(yg + (size_t)row * 256 + c);
                    const f32x4 v0 = acc[ai][bj][m][0] + b0, v1 = acc[ai][bj][m][1] + b1;
                    u32x4 w;
                    w.x = cvt_pk_bf16(bf_lo(yw.x) * sigmoidf_(v0[0]), bf_hi(yw.x) * sigmoidf_(v0[1]));
                    w.y = cvt_pk_bf16(bf_lo(yw.y) * sigmoidf_(v0[2]), bf_hi(yw.y) * sigmoidf_(v0[3]));
                    w.z = cvt_pk_bf16(bf_lo(yw.z) * sigmoidf_(v1[0]), bf_hi(yw.z) * sigmoidf_(v1[1]));
                    w.w = cvt_pk_bf16(bf_lo(yw.w) * sigmoidf_(v1[2]), bf_hi(yw.w) * sigmoidf_(v1[3]));
                    *(u32x4*)(mix + (size_t)row * 1024 + 768 + c) = w; } }
    }
};
template <class Epi, class Sched, bool ALIGN_EPI = false, bool SP2 = false>
__device__ __forceinline__ void gemm_phase(PG8_LAS unsigned char* lds, const Gemm g, const Sched& S, const Epi& E) {
    int tid_l = threadIdx.x; asm volatile("" : "+v"(tid_l));
    const int tid = tid_l, wid = __builtin_amdgcn_readfirstlane(tid >> 6), lane = tid & 63, wr = wid >> 2, wc = wid & 3, fr = lane & 15, fq = lane >> 4;
    const int K = g.K, nt = K / BK;
    unsigned voffA[2], voffB[2];
#pragma unroll
    for (int i = 0; i < 2; ++i) { int R, C; stage_rc(tid * 16 + i * 8192, R, C); const int Rb = Epi::PERM ? ((R & ~31) + perm32(R & 31)) : R;
        voffA[i] = (unsigned)(R * K + C) * 2u; voffB[i] = (unsigned)(Rb * K + C) * 2u; }
    const size_t kstep = (size_t)(BK * 2);
    const size_t hstep = (size_t)HALF * K * 2;
    const size_t tstep = 2 * hstep;
    const unsigned ldsw = (unsigned)wid * 1024u;
    const int aoff = lds_byte(wr * 64 + fr, fq * 8), boff = lds_byte(wc * 32 + fr, fq * 8);
#define PG8_SA(b, h) (((b) * 2 + (h)) * HTB)
#define PG8_SB(b, h) ((4 + (b) * 2 + (h)) * HTB)
#define PG8_STAGE(bufoff, gbase, voff) do { _Pragma("unroll") for (int _i = 0; _i < 2; ++_i) \
        __builtin_amdgcn_global_load_lds((const unsigned*)((const char*)(gbase) + (voff)[_i]), (PG8_LAS unsigned*)(lds + (bufoff) + ldsw + _i * 8192), 16, 0, 0); } while (0)
#define PG8_LDA(dst, b, h) do { _Pragma("unroll") for (int m = 0; m < 4; ++m) _Pragma("unroll") for (int k = 0; k < 2; ++k) dst[m][k] = *(const PG8_LAS bf16x8*)(lds + PG8_SA(b, h) + aoff + m * 2048 + k * 1024); } while (0)
#define PG8_LDB(dst, b, h) do { _Pragma("unroll") for (int n = 0; n < 2; ++n) _Pragma("unroll") for (int k = 0; k < 2; ++k) dst[n][k] = *(const PG8_LAS bf16x8*)(lds + PG8_SB(b, h) + boff + n * 2048 + k * 1024); } while (0)
#define PG8_MMA(ai, bj, At, Bt) do { __builtin_amdgcn_s_setprio(1); _Pragma("unroll") for (int m = 0; m < 4; ++m) _Pragma("unroll") for (int n = 0; n < 2; ++n) _Pragma("unroll") for (int k = 0; k < 2; ++k) \
        acc[ai][bj][m][n] = __builtin_amdgcn_mfma_f32_16x16x32_bf16(Bt[n][k], At[m][k], acc[ai][bj][m][n], 0, 0, 0); __builtin_amdgcn_s_setprio(0); } while (0)
#define PG8_WAIT_V(n) asm volatile("s_waitcnt vmcnt(" #n ")" ::: "memory")
#define PG8_WAIT_L(n) asm volatile("s_waitcnt lgkmcnt(" #n ")" ::: "memory")
#define PG8_BAR __builtin_amdgcn_s_barrier()
#define PG8_SCHED __builtin_amdgcn_sched_barrier(0)
    Unit cur, nxt; int ui = 0;
    if (!S.next(0, cur)) return;
    f32x4 acc[2][2][4][2];
#pragma unroll
    for (int a = 0; a < 2; ++a)
#pragma unroll
        for (int b = 0; b < 2; ++b)
#pragma unroll
            for (int m = 0; m < 4; ++m)
#pragma unroll
                for (int n = 0; n < 2; ++n) acc[a][b][m][n] = (f32x4){0.f, 0.f, 0.f, 0.f};
    bf16x8 At[4][2], B0[2][2], B1[2][2];
    const char* cA = (const char*)g.A + (size_t)cur.pm * tstep; const char* cB = (const char*)g.Bt + (size_t)cur.pn * tstep;
    S.a_ready(cur);
    if constexpr (SP2) {
        PG8_STAGE(PG8_SB(0, 0), cB, voffB); PG8_STAGE(PG8_SB(0, 1), cB + hstep, voffB); PG8_STAGE(PG8_SA(0, 0), cA, voffA); PG8_STAGE(PG8_SA(0, 1), cA + hstep, voffA);
        if (wr == 1) PG8_BAR;
        PG8_WAIT_V(2); PG8_BAR;
        PG8_STAGE(PG8_SB(1, 0), cB + kstep, voffB); PG8_STAGE(PG8_SA(1, 0), cA + kstep, voffA); PG8_STAGE(PG8_SB(1, 1), cB + hstep + kstep, voffB);
        PG8_WAIT_V(6); PG8_BAR;
    } else {
        PG8_STAGE(PG8_SB(0, 0), cB, voffB); PG8_STAGE(PG8_SA(0, 0), cA, voffA); PG8_STAGE(PG8_SB(0, 1), cB + hstep, voffB); PG8_STAGE(PG8_SA(0, 1), cA + hstep, voffA);
        if (wr == 1) PG8_BAR;
        PG8_WAIT_V(4); PG8_BAR;
        PG8_STAGE(PG8_SB(1, 0), cB + kstep, voffB); PG8_STAGE(PG8_SA(1, 0), cA + kstep, voffA); PG8_STAGE(PG8_SB(1, 1), cB + hstep + kstep, voffB);
        PG8_WAIT_V(6); PG8_BAR;
    }
    for (;;) {
        const bool has_next = S.next(ui + 1, nxt);
        const char* nA = has_next ? (const char*)g.A + (size_t)nxt.pm * tstep : cA; const char* nB = has_next ? (const char*)g.Bt + (size_t)nxt.pn * tstep : cB;
        for (int t = 0; t < nt; t += 2) {
            const bool last = (t == nt - 2);
            const char* a1 = cA + (size_t)(t + 1) * kstep;
            const char* a2 = last ? nA : cA + (size_t)(t + 2) * kstep; const char* b2 = last ? nB : cB + (size_t)(t + 2) * kstep;
            const char* a3 = a2 + kstep; const char* b3 = b2 + kstep;
            if (last && has_next) S.a_ready(nxt);
            if constexpr (SP2) {
            PG8_LDB(B0, 0, 0); PG8_LDB(B1, 0, 1); PG8_SCHED; PG8_LDA(At, 0, 0); PG8_STAGE(PG8_SA(1, 1), a1 + hstep, voffA);
            PG8_WAIT_V(8); PG8_WAIT_L(0); PG8_BAR; PG8_MMA(0, 0, At, B0); PG8_MMA(0, 1, At, B1); PG8_BAR; PG8_SCHED;
            PG8_LDA(At, 0, 1); PG8_STAGE(PG8_SB(0, 0), b2, voffB); PG8_STAGE(PG8_SB(0, 1), b2 + hstep, voffB); PG8_STAGE(PG8_SA(0, 0), a2, voffA);
            PG8_WAIT_V(8); PG8_WAIT_L(0); PG8_BAR; PG8_MMA(1, 0, At, B0); PG8_MMA(1, 1, At, B1); PG8_BAR; PG8_SCHED;
            PG8_LDB(B0, 1, 0); PG8_LDB(B1, 1, 1); PG8_SCHED; PG8_LDA(At, 1, 0); PG8_STAGE(PG8_SA(0, 1), a2 + hstep, voffA);
            PG8_WAIT_V(8); PG8_WAIT_L(0); PG8_BAR; PG8_MMA(0, 0, At, B0); PG8_MMA(0, 1, At, B1); PG8_BAR; PG8_SCHED;
            PG8_LDA(At, 1, 1); PG8_STAGE(PG8_SB(1, 0), b3, voffB); PG8_STAGE(PG8_SB(1, 1), b3 + hstep, voffB); PG8_STAGE(PG8_SA(1, 0), a3, voffA);
            PG8_WAIT_V(8); PG8_WAIT_L(0); PG8_BAR; PG8_MMA(1, 0, At, B0); PG8_MMA(1, 1, At, B1); PG8_BAR; PG8_SCHED;
            } else {
            PG8_LDB(B0, 0, 0); PG8_SCHED; PG8_LDA(At, 0, 0); PG8_STAGE(PG8_SA(1, 1), a1 + hstep, voffA);
            PG8_WAIT_L(8); PG8_BAR; PG8_WAIT_L(0); PG8_MMA(0, 0, At, B0); PG8_BAR; PG8_SCHED;
            PG8_LDB(B1, 0, 1); PG8_STAGE(PG8_SB(0, 0), b2, voffB);
            PG8_BAR; PG8_WAIT_L(0); PG8_MMA(0, 1, At, B1); PG8_BAR;
            PG8_LDA(At, 0, 1); PG8_STAGE(PG8_SA(0, 0), a2, voffA);
            PG8_BAR; PG8_WAIT_L(0); PG8_MMA(1, 0, At, B0); PG8_BAR; PG8_SCHED;
            PG8_STAGE(PG8_SB(0, 1), b2 + hstep, voffB);
            PG8_WAIT_V(6); PG8_BAR; PG8_MMA(1, 1, At, B1); PG8_BAR;
            PG8_LDB(B0, 1, 0); PG8_SCHED; PG8_LDA(At, 1, 0); PG8_STAGE(PG8_SA(0, 1), a2 + hstep, voffA);
            PG8_WAIT_L(8); PG8_BAR; PG8_WAIT_L(0); PG8_MMA(0, 0, At, B0); PG8_BAR; PG8_SCHED;
            PG8_LDB(B1, 1, 1); PG8_STAGE(PG8_SB(1, 0), b3, voffB);
            PG8_BAR; PG8_WAIT_L(0); PG8_MMA(0, 1, At, B1); PG8_BAR;
            PG8_LDA(At, 1, 1); PG8_STAGE(PG8_SA(1, 0), a3, voffA);
            PG8_BAR; PG8_WAIT_L(0); PG8_MMA(1, 0, At, B0); PG8_BAR; PG8_SCHED;
            PG8_STAGE(PG8_SB(1, 1), b3 + hstep, voffB);
            PG8_WAIT_V(6); PG8_BAR; PG8_MMA(1, 1, At, B1); PG8_BAR;
            }
        }
        if constexpr (ALIGN_EPI) { if (wr == 0) PG8_BAR; }
        if constexpr (!Epi::AFTER_DRAIN) { E(acc, cur, wr, wc, fr, fq); S.done(cur); }
        if (!has_next) break;
#pragma unroll
        for (int a = 0; a < 2; ++a)
#pragma unroll
            for (int b = 0; b < 2; ++b)
#pragma unroll
                for (int m = 0; m < 4; ++m)
#pragma unroll
                    for (int n = 0; n < 2; ++n) acc[a][b][m][n] = (f32x4){0.f, 0.f, 0.f, 0.f};
        cur = nxt; cA = nA; cB = nB; ++ui;
        if constexpr (ALIGN_EPI) { if (wr == 1) PG8_BAR; }
    }
    PG8_WAIT_V(0);
    if constexpr (!ALIGN_EPI) { if (wr == 0) PG8_BAR; }
    PG8_BAR;
    if constexpr (Epi::AFTER_DRAIN) { E.fused(acc, cur, wr, wc, fr, fq, lds, wid, lane); S.done(cur); }
#undef PG8_SA
#undef PG8_SB
#undef PG8_STAGE
#undef PG8_LDA
#undef PG8_LDB
#undef PG8_MMA
#undef PG8_WAIT_V
#undef PG8_WAIT_L
#undef PG8_BAR
#undef PG8_SCHED
}
}

constexpr int DM = 1024, BATCH = 8, SEQ = 4096, DEPTH = 4, MT = BATCH * SEQ;
constexpr int INW = 2304, FFW = 4096, PLEW = 256, SSW = 256;
constexpr int ZK = 512, ZV = 1024, ZC = 1536, ZS = 2048;
constexpr float EPS = 1e-6f;
constexpr int NWAVES = 8, NTHREADS = 512;
constexpr int LDS_BYTES = 147456;
constexpr size_t MiB = 1u << 20;
constexpr size_t WS_SSQA = 1 * MiB, WS_SSQB = 3 * MiB, WS_SSQC = 5 * MiB;
constexpr size_t WS_W = 8 * MiB;
constexpr size_t LW_IN = 0, LW_GLU = LW_IN + (size_t)INW * DM, LW_OUT = LW_GLU + (size_t)SSW * SSW, LW_FF1 = LW_OUT + (size_t)DM * DM,
                 LW_FF2 = LW_FF1 + (size_t)FFW * DM, LW_GATE = LW_FF2 + (size_t)DM * FFW, LW_PLE = LW_GATE + (size_t)DM * DM, LW_ELEMS = LW_PLE + (size_t)DM * PLEW;
constexpr size_t WS_XN = 109 * MiB, WS_PP = 173 * MiB, WS_PBF = 237 * MiB, WS_R = 253 * MiB;
constexpr size_t WS_Z = WS_R, WS_MIX = WS_R + 144 * MiB, WS_YG = WS_MIX + 64 * MiB, WS_STASH = WS_YG + 16 * MiB, WS_HID = WS_R, WS_END = WS_R + 256 * MiB, WS_XN2 = WS_MIX;
static_assert(WS_W + LW_ELEMS * 2 * DEPTH <= WS_XN, "weights fit");
static_assert(WS_STASH + 32 * MiB <= WS_END, "region R");

typedef unsigned short bf16_t;
typedef short bf16x8 __attribute__((ext_vector_type(8)));
typedef short s16x4 __attribute__((ext_vector_type(4)));
typedef float f32x4 __attribute__((ext_vector_type(4)));
typedef float f32x16 __attribute__((ext_vector_type(16)));
typedef unsigned u32x4 __attribute__((ext_vector_type(4)));
typedef unsigned u32x2 __attribute__((ext_vector_type(2)));
#define LAS __attribute__((address_space(3)))

__device__ __forceinline__ unsigned cvtpk(float lo, float hi) { unsigned r; asm volatile("v_cvt_pk_bf16_f32 %0, %1, %2" : "=v"(r) : "v"(lo), "v"(hi)); return r; }
__device__ __forceinline__ float bflo(unsigned w) { return __uint_as_float(w << 16); }
__device__ __forceinline__ float bfhi(unsigned w) { return __uint_as_float(w & 0xffff0000u); }
__device__ __forceinline__ float sigm(float x) { return __builtin_amdgcn_rcpf(1.0f + __expf(-x)); }
__device__ __forceinline__ float wave_sum(float v) {
#pragma unroll
    for (int o = 1; o < 64; o <<= 1) v += __shfl_xor(v, o);
    return v;
}

struct Args { const float* in[32]; float* out; unsigned char* ws; int ph_lo, ph_hi; };
struct KA { const __attribute__((address_space(4))) Args* p; __device__ __forceinline__ const __attribute__((address_space(4))) Args* operator->() const { return p; } };

__device__ __forceinline__ void transpose_item(const float* W, const float* gain, int K, int N, bf16_t* WT, float* scr, int item, int lane, bool perm = false) {
    const int nblk = N / 64, kb = item / nblk, nb = item % nblk, k0 = 64 * kb, n0 = 64 * nb;
    const int kk = lane >> 4, n4 = (lane & 15) * 4;
#pragma unroll 4
    for (int i = 0; i < 16; ++i) { const int k = 4 * i + kk; f32x4 v = *(const f32x4*)(W + (size_t)(k0 + k) * N + n0 + n4); if (gain) v = v * gain[k0 + k]; *(f32x4*)(scr + k * 68 + n4) = v; }
    asm volatile("s_waitcnt lgkmcnt(0)" ::: "memory");
    const int c = lane & 7;
#pragma unroll
    for (int j = 0; j < 8; ++j) { const int n = (lane >> 3) + 8 * j; const float* s = scr + (8 * c) * 68 + n; const int nl = n0 + n;
        const int nr = perm ? (nl & ~255) + 32 * (4 * ((nl >> 5) & 1) + (((nl >> 5) & 7) >> 1)) + (nl & 31) : nl;
        u32x4 o; o.x = cvtpk(s[0 * 68], s[1 * 68]); o.y = cvtpk(s[2 * 68], s[3 * 68]); o.z = cvtpk(s[4 * 68], s[5 * 68]); o.w = cvtpk(s[6 * 68], s[7 * 68]);
        *(u32x4*)(WT + (size_t)nr * K + k0 + 8 * c) = o; }
    asm volatile("s_waitcnt lgkmcnt(0)" ::: "memory");
}

__device__ __forceinline__ void prologue_phase(const KA a, unsigned char* lds, int bx, int G) {
    int tid_l = threadIdx.x; asm volatile("" : "+v"(tid_l));
    const int tid = tid_l, lane = tid & 63, wave = tid >> 6;
    float* scr = (float*)(lds + wave * 17408);
    const int gw = bx * NWAVES + wave, NGW = G * NWAVES;
    constexpr int I_IN = (DM / 64) * (INW / 64), I_GLU = (SSW / 64) * (SSW / 64), I_OUT = (DM / 64) * (DM / 64), I_FF1 = (DM / 64) * (FFW / 64),
                  I_FF2 = (FFW / 64) * (DM / 64), I_GATE = I_OUT, I_PLE = (PLEW / 64) * (DM / 64), I_LAYER = I_IN + I_GLU + I_OUT + I_FF1 + I_FF2 + I_GATE + I_PLE;
    for (int it = gw; it < I_LAYER * DEPTH; it += NGW) {
        const int L = it / I_LAYER; int r = it % I_LAYER;
        bf16_t* wl = (bf16_t*)(a->ws + WS_W) + (size_t)L * LW_ELEMS;
        if (r < I_IN) { transpose_item(a->in[3] + (size_t)L * DM * INW, a->in[2] + L * DM, DM, INW, wl + LW_IN, scr, r, lane, true); continue; } r -= I_IN;
        if (r < I_GLU) { transpose_item(a->in[23] + (size_t)L * SSW * SSW, nullptr, SSW, SSW, wl + LW_GLU, scr, r, lane); continue; } r -= I_GLU;
        if (r < I_OUT) { transpose_item(a->in[25] + (size_t)L * DM * DM, nullptr, DM, DM, wl + LW_OUT, scr, r, lane); continue; } r -= I_OUT;
        if (r < I_FF1) { transpose_item(a->in[27] + (size_t)L * DM * FFW, a->in[26] + L * DM, DM, FFW, wl + LW_FF1, scr, r, lane); continue; } r -= I_FF1;
        if (r < I_FF2) { transpose_item(a->in[28] + (size_t)L * FFW * DM, nullptr, FFW, DM, wl + LW_FF2, scr, r, lane); continue; } r -= I_FF2;
        if (r < I_GATE) { transpose_item(a->in[30] + (size_t)L * DM * DM, a->in[29] + L * DM, DM, DM, wl + LW_GATE, scr, r, lane); continue; } r -= I_GATE;
        transpose_item(a->in[31] + (size_t)L * PLEW * DM, nullptr, PLEW, DM, wl + LW_PLE, scr, r, lane);
    }
    const float* x = a->in[0]; bf16_t* xn = (bf16_t*)(a->ws + WS_XN); float* ssq = (float*)(a->ws + WS_SSQA);
    for (int m = gw; m < MT; m += NGW) {
        const f32x4* xr = (const f32x4*)(x + (size_t)m * DM) + lane; u32x2* o8 = (u32x2*)(xn + (size_t)m * DM) + lane;
        float s = 0.f;
#pragma unroll
        for (int j = 0; j < 4; ++j) { const f32x4 v = xr[64 * j]; s += (v[0] * v[0] + v[1] * v[1]) + (v[2] * v[2] + v[3] * v[3]);
            u32x2 w; w.x = cvtpk(v[0], v[1]); w.y = cvtpk(v[2], v[3]); o8[64 * j] = w; }
        s = wave_sum(s);
        if (lane < 16) ssq[(size_t)m * 16 + lane] = lane == 0 ? s : 0.f;
    }
}

__device__ __forceinline__ void pcvt_rows(const KA a, int L, int row_lo, int nrows) {
    int tid_l = threadIdx.x; asm volatile("" : "+v"(tid_l));
    const int tid = tid_l, lane = tid & 63, wave = tid >> 6;
    bf16_t* pbf = (bf16_t*)(a->ws + WS_PBF); const float* p = a->in[1] + (size_t)L * MT * PLEW;
    for (int i = wave * 4; i < nrows; i += NWAVES * 4) { f32x4 pv[4];
#pragma unroll
        for (int j = 0; j < 4; ++j) pv[j] = *((const f32x4*)(p + (size_t)(row_lo + i + j) * PLEW) + lane);
#pragma unroll
        for (int j = 0; j < 4; ++j) { u32x2 w; w.x = cvtpk(pv[j][0], pv[j][1]); w.y = cvtpk(pv[j][2], pv[j][3]); *((u32x2*)(pbf + (size_t)(row_lo + i + j) * PLEW) + lane) = w; } }
}

__device__ __forceinline__ void conv_unit(const KA a, int L, int unit, unsigned char* lds) {
    int tid_l = threadIdx.x; asm volatile("" : "+v"(tid_l));
    const int tid = tid_l, lane = tid & 63, wave = tid >> 6;
    const int b = unit >> 7, t0 = (unit & 127) * 32; const size_t rb = (size_t)b * SEQ;
    const bf16_t* z = (const bf16_t*)(a->ws + WS_Z); bf16_t* mix = (bf16_t*)(a->ws + WS_MIX);
    float* hcv = (float*)lds; float* cv = (float*)(lds + 62 * 256 * 4);
    u32x4 aw[4], gw[4];
#pragma unroll
    for (int i = 0; i < 4; ++i) { const int it = tid + NTHREADS * i; const int r = it >> 5, ch = (it & 31) * 8; const int t = t0 - 30 + r;
        if (it < 62 * 32 && t >= 0) { const bf16_t* zr = z + (rb + t) * INW + ZC + ch; aw[i] = *(const u32x4*)zr; gw[i] = *(const u32x4*)(zr + 256); }
        else { aw[i] = (u32x4){0u, 0u, 0u, 0u}; gw[i] = (u32x4){0u, 0u, 0u, 0u}; } }
    const int c = tid & 255, half = tid >> 8; const float* cw = a->in[11] + (size_t)L * 31 * 256 + c; const float cb = a->in[12][L * 256 + c];
    float w[31];
#pragma unroll
    for (int k = 0; k < 31; ++k) w[k] = cw[k * 256];
#pragma unroll
    for (int i = 0; i < 4; ++i) { const int it = tid + NTHREADS * i; const int r = it >> 5, ch = (it & 31) * 8;
        if (it < 62 * 32) { float v[8];
            v[0] = bflo(aw[i].x) * sigm(bflo(gw[i].x)); v[1] = bfhi(aw[i].x) * sigm(bfhi(gw[i].x)); v[2] = bflo(aw[i].y) * sigm(bflo(gw[i].y)); v[3] = bfhi(aw[i].y) * sigm(bfhi(gw[i].y));
            v[4] = bflo(aw[i].z) * sigm(bflo(gw[i].z)); v[5] = bfhi(aw[i].z) * sigm(bfhi(gw[i].z)); v[6] = bflo(aw[i].w) * sigm(bflo(gw[i].w)); v[7] = bfhi(aw[i].w) * sigm(bfhi(gw[i].w));
            *(f32x4*)(hcv + r * 256 + ch) = (f32x4){v[0], v[1], v[2], v[3]}; *(f32x4*)(hcv + r * 256 + ch + 4) = (f32x4){v[4], v[5], v[6], v[7]}; } }
    __syncthreads();
    { float win[46];
#pragma unroll
        for (int j = 0; j < 46; ++j) win[j] = hcv[(half * 16 + j) * 256 + c];
#pragma unroll
        for (int tt = 0; tt < 16; ++tt) { float acc = cb;
#pragma unroll
            for (int k = 0; k < 31; ++k) acc += w[k] * win[tt + k];
            cv[(half * 16 + tt) * 256 + c] = acc; } }
    __syncthreads();
    { const f32x4 g = *((const f32x4*)(a->in[13] + L * 256) + lane), bb = *((const f32x4*)(a->in[14] + L * 256) + lane);
#pragma unroll
        for (int i = 0; i < 4; ++i) { const int t = wave * 4 + i; const f32x4 xv = *((const f32x4*)(cv + t * 256) + lane);
            const float mu = wave_sum((xv[0] + xv[1]) + (xv[2] + xv[3])) * (1.0f / 256.0f);
            const f32x4 d = xv - mu; const float var = wave_sum((d[0] * d[0] + d[1] * d[1]) + (d[2] * d[2] + d[3] * d[3])) * (1.0f / 256.0f);
            const float rs = __builtin_amdgcn_rsqf(var + EPS); f32x4 y = d * rs * g + bb;
#pragma unroll
            for (int e = 0; e < 4; ++e) y[e] = y[e] * sigm(y[e]);
            u32x2 w2; w2.x = cvtpk(y[0], y[1]); w2.y = cvtpk(y[2], y[3]); *((u32x2*)(mix + (rb + t0 + t) * DM + 512) + lane) = w2; } }
    __syncthreads();
}

__device__ __forceinline__ float gelu_tanh(float y) { const float z = 0.7978845608028654f * (y + 0.044715f * y * y * y); const float t = 1.0f - 2.0f * __builtin_amdgcn_rcpf(1.0f + __expf(2.0f * z)); return 0.5f * y * (1.0f + t); }

__device__ __forceinline__ void ssm_bfrag(const KA a, int lg, float dt, int nb, int lane, bf16x8& bhi, bf16x8& blo) {
    const int p = (lane & 31) + 32 * (nb & 1), c0 = 8 * (lane >> 5);
    const float lr = a->in[15][lg * 64 + p], li = a->in[16][lg * 64 + p]; const float ea = expf(lr * dt), th = li * dt; const float par = ea * cosf(th), pai = ea * sinf(th);
    const float den = 1.0f / (lr * lr + li * li); const float nr = par - 1.0f; const float cr = (nr * lr + pai * li) * den, ci = (pai * lr - nr * li) * den;
    const float* bre = a->in[18] + ((size_t)lg * 64 + p) * 16 + c0; const float* bim = a->in[19] + ((size_t)lg * 64 + p) * 16 + c0;
    float v[8];
    { const f32x4 xr0 = *(const f32x4*)bre, xr1 = *(const f32x4*)(bre + 4), xi0 = *(const f32x4*)bim, xi1 = *(const f32x4*)(bim + 4);
      const float xs[8] = {xr0[0], xr0[1], xr0[2], xr0[3], xr1[0], xr1[1], xr1[2], xr1[3]}, ys[8] = {xi0[0], xi0[1], xi0[2], xi0[3], xi1[0], xi1[1], xi1[2], xi1[3]};
#pragma unroll
      for (int j = 0; j < 8; ++j) v[j] = (nb >> 1) ? (cr * ys[j] + ci * xs[j]) : (cr * xs[j] - ci * ys[j]); }
    u32x4 wh, wl; float rem[8];
    wh.x = cvtpk(v[0], v[1]); wh.y = cvtpk(v[2], v[3]); wh.z = cvtpk(v[4], v[5]); wh.w = cvtpk(v[6], v[7]);
    rem[0] = v[0] - bflo(wh.x); rem[1] = v[1] - bfhi(wh.x); rem[2] = v[2] - bflo(wh.y); rem[3] = v[3] - bfhi(wh.y);
    rem[4] = v[4] - bflo(wh.z); rem[5] = v[5] - bfhi(wh.z); rem[6] = v[6] - bflo(wh.w); rem[7] = v[7] - bfhi(wh.w);
    wl.x = cvtpk(rem[0], rem[1]); wl.y = cvtpk(rem[2], rem[3]); wl.z = cvtpk(rem[4], rem[5]); wl.w = cvtpk(rem[6], rem[7]);
    bhi = *reinterpret_cast<bf16x8*>(&wh); blo = *reinterpret_cast<bf16x8*>(&wl);
}
__device__ __forceinline__ void ssm_s1_block(const bf16_t* usb, float* bur, float* bui, int blk, int lane, bf16x8 bhi, bf16x8 blo) {
    constexpr int XS = 68; const int mb = blk >> 2, nb = blk & 3;
    const bf16x8 af = *(const bf16x8*)(usb + (mb * 32 + (lane & 31)) * 16 + 8 * (lane >> 5));
    f32x16 acc = f32x16{};
    acc = __builtin_amdgcn_mfma_f32_32x32x16_bf16(af, bhi, acc, 0, 0, 0);
    acc = __builtin_amdgcn_mfma_f32_32x32x16_bf16(af, blo, acc, 0, 0, 0);
    float* dst = ((nb >> 1) ? bui : bur) + (lane & 31) + 32 * (nb & 1); const int hi = lane >> 5;
#pragma unroll
    for (int r = 0; r < 16; ++r) dst[(mb * 32 + (r & 3) + 8 * (r >> 2) + 4 * hi) * XS] = acc[r];
}
__device__ __forceinline__ void ssm_unit(const KA a, int L, int unit, unsigned char* lds) {
    int tid_l = threadIdx.x; asm volatile("" : "+v"(tid_l));
    const int tid = tid_l, lane = tid & 63, wave = __builtin_amdgcn_readfirstlane(tid >> 6);
    const int b = unit >> 4, g = unit & 15, lg = L * 16 + g; const size_t rb = (size_t)b * SEQ;
    const bf16_t* z = (const bf16_t*)(a->ws + WS_Z); bf16_t* yg = (bf16_t*)(a->ws + WS_YG);
    constexpr int XS = 68, XF = 132, NCH = SEQ / 64;
    constexpr int OFF_BU = 8192, BU_BYTES = 2 * 64 * XS * 4, OFF_X = OFF_BU + 2 * BU_BYTES, X_BYTES = 64 * XF * 4;
    static_assert(OFF_X + 2 * X_BYTES <= LDS_BYTES - 64, "ssm LDS map");
    const float dt = expf(a->in[17][lg]);
    float ar, ai;
    { const float lr = a->in[15][lg * 64 + lane], li = a->in[16][lg * 64 + lane]; const float ea = expf(lr * dt), th = li * dt; ar = ea * cosf(th); ai = ea * sinf(th); }
    bf16x8 bhi, blo, bhi0, blo0;
    ssm_bfrag(a, lg, dt, wave & 3, lane, bhi, blo); ssm_bfrag(a, lg, dt, 0, lane, bhi0, blo0);
    bf16x8 w3[4];
    { const int c = lane & 15, kg = lane >> 4;
      f32x4 cf[4][2];
#pragma unroll
      for (int s4 = 0; s4 < 4; ++s4) { const float* src = (s4 < 2 ? a->in[20] : a->in[21]) + ((size_t)lg * 16 + c) * 64 + 32 * (s4 & 1) + 8 * kg; cf[s4][0] = *(const f32x4*)src; cf[s4][1] = *(const f32x4*)(src + 4); }
#pragma unroll
      for (int s4 = 0; s4 < 4; ++s4) { const float sg = s4 < 2 ? 1.f : -1.f; const f32x4 c0 = cf[s4][0] * sg, c1 = cf[s4][1] * sg;
          u32x4 w; w.x = cvtpk(c0[0], c0[1]); w.y = cvtpk(c0[2], c0[3]); w.z = cvtpk(c1[0], c1[1]); w.w = cvtpk(c1[2], c1[3]);
          w3[s4] = *reinterpret_cast<bf16x8*>(&w); } }
    const float dco = a->in[22][lg * 16 + (lane & 15)];
    float sr = 0.f, si = 0.f;
    const bool loader = (wave == 2 || wave == 3); const int lidx = tid - 128, lt = lidx >> 1, lhf = lidx & 1;
    const bf16_t* usrc = z + (rb + (loader ? lt : 0)) * INW + ZS + g * 16 + (loader ? lhf : 0) * 8;
    u32x4 ureg = (u32x4){0u, 0u, 0u, 0u};
    if (loader) ureg = *(const u32x4*)usrc;
    for (int it = -2; it <= NCH; ++it) {
        if (loader) { const int ck = it + 2;
            if (ck < NCH) *(u32x4*)((bf16_t*)(lds + (ck & 3) * 2048) + lt * 16 + lhf * 8) = ureg;
            if (ck + 1 < NCH) ureg = *(const u32x4*)(usrc + (size_t)(ck + 1) * 64 * INW); }
        { const int ck = it + 1;
          if (ck >= 0 && ck < NCH && wave >= 1) { const bf16_t* usb = (const bf16_t*)(lds + (ck & 3) * 2048); float* bur = (float*)(lds + OFF_BU + (ck & 1) * BU_BYTES); float* bui = bur + 64 * XS;
              ssm_s1_block(usb, bur, bui, wave, lane, bhi, blo);
              if (wave == 1) ssm_s1_block(usb, bur, bui, 0, lane, bhi0, blo0); } }
        if (wave == 0 && it >= 0 && it < NCH) {
            const float* bur = (const float*)(lds + OFF_BU + (it & 1) * BU_BYTES); const float* bui = bur + 64 * XS; float* X = (float*)(lds + OFF_X + (it & 1) * X_BYTES);
            const int p = lane; float rr[8], ii[8];
#pragma unroll
            for (int j = 0; j < 8; ++j) { rr[j] = bur[j * XS + p]; ii[j] = bui[j * XS + p]; }
#pragma unroll
            for (int blk = 0; blk < 8; ++blk) { float nr_[8], ni_[8];
                if (blk < 7) {
#pragma unroll
                    for (int j = 0; j < 8; ++j) { nr_[j] = bur[((blk + 1) * 8 + j) * XS + p]; ni_[j] = bui[((blk + 1) * 8 + j) * XS + p]; } }
#pragma unroll
                for (int j = 0; j < 8; ++j) { const float n_r = ar * sr - ai * si + rr[j], n_i = ar * si + ai * sr + ii[j]; sr = n_r; si = n_i;
                    X[(blk * 8 + j) * XF + p] = sr; X[(blk * 8 + j) * XF + 64 + p] = si; }
                if (blk < 7) {
#pragma unroll
                    for (int j = 0; j < 8; ++j) { rr[j] = nr_[j]; ii[j] = ni_[j]; } } } }
        { const int ck = it - 1;
          if (ck >= 0 && wave >= 4) { const int tb = wave - 4, c = lane & 15, kg = lane >> 4; const int t0 = ck * 64;
              const float* X = (const float*)(lds + OFF_X + (ck & 1) * X_BYTES); const bf16_t* usb = (const bf16_t*)(lds + (ck & 3) * 2048);
              f32x4 acc = (f32x4){0.f, 0.f, 0.f, 0.f};
#pragma unroll
              for (int s4 = 0; s4 < 4; ++s4) { const f32x4* xp = (const f32x4*)(X + (tb * 16 + (lane & 15)) * XF + 32 * s4 + 8 * kg); const f32x4 x0 = xp[0], x1 = xp[1];
                  u32x4 w; w.x = cvtpk(x0[0], x0[1]); w.y = cvtpk(x0[2], x0[3]); w.z = cvtpk(x1[0], x1[1]); w.w = cvtpk(x1[2], x1[3]);
                  acc = __builtin_amdgcn_mfma_f32_16x16x32_bf16(*reinterpret_cast<bf16x8*>(&w), w3[s4], acc, 0, 0, 0); }
#pragma unroll
              for (int r = 0; r < 4; ++r) { const int t = tb * 16 + 4 * kg + r; const float u = __uint_as_float((unsigned)usb[t * 16 + c] << 16);
                  const float y = acc[r] + dco * u; const unsigned w = cvtpk(gelu_tanh(y), 0.f);
                  __hip_atomic_store(yg + (rb + t0 + t) * SSW + g * 16 + c, (bf16_t)(w & 0xffffu), __ATOMIC_RELAXED, __HIP_MEMORY_SCOPE_AGENT); } } }
        __syncthreads();
    }
}

namespace att {
constexpr float SCALE = 0.125f, THR = 8.f;
constexpr int SHM_V = 64 * 128 * 2, SHM_K = 64 * 64 * 2;
constexpr int OFF_V = 0, OFF_K = 2 * SHM_V, OFF_WS = OFF_K + 2 * SHM_K;
#define KSWZ(row, colB) ((row) * 128 + ((colB) ^ ((((row) >> 1) & 7) << 4)))
#define SBAR() __builtin_amdgcn_sched_barrier(0)
__device__ __forceinline__ int crow(int r, int hi) { return (r & 3) + 8 * (r >> 2) + 4 * hi; }

__device__ __forceinline__ void partialSM(f32x16& p0, f32x16& p1, float& m_reg, float& alpha) {
    constexpr float C = SCALE * 1.4426950408889634f;
    float pmax = p0[0];
#pragma unroll
    for (int r = 1; r < 16; ++r) pmax = fmaxf(pmax, p0[r]);
#pragma unroll
    for (int r = 0; r < 16; ++r) pmax = fmaxf(pmax, p1[r]);
    { auto rr = __builtin_amdgcn_permlane32_swap(__float_as_uint(pmax), __float_as_uint(pmax), false, false);
      pmax = fmaxf(__uint_as_float(rr[0]), __uint_as_float(rr[1])); }
    float mn;
    if (__builtin_expect(__all(pmax - m_reg <= THR / SCALE), 1)) { mn = m_reg; alpha = 1.f; }
    else { mn = fmaxf(m_reg, pmax); alpha = __builtin_amdgcn_exp2f((m_reg - mn) * C); m_reg = mn; }
    const float mnC = -mn * C;
#pragma unroll
    for (int r = 0; r < 16; ++r) p0[r] = __builtin_amdgcn_exp2f(fmaf(p0[r], C, mnC));
#pragma unroll
    for (int r = 0; r < 16; ++r) p1[r] = __builtin_amdgcn_exp2f(fmaf(p1[r], C, mnC));
}
__device__ __forceinline__ void finishSM(f32x16& p0, f32x16& p1, float alpha, float& l_reg, bf16x8& pa0, bf16x8& pa1, bf16x8& pa2, bf16x8& pa3) {
    float ps = 0;
#pragma unroll
    for (int r = 0; r < 16; ++r) ps += p0[r];
#pragma unroll
    for (int r = 0; r < 16; ++r) ps += p1[r];
    { auto rr = __builtin_amdgcn_permlane32_swap(__float_as_uint(ps), __float_as_uint(ps), false, false);
      ps = __uint_as_float(rr[0]) + __uint_as_float(rr[1]); }
    l_reg = l_reg * alpha + ps;
#define PK4(P, BASE, OUT) do { unsigned a0 = cvtpk(P[BASE + 0], P[BASE + 1]), a1 = cvtpk(P[BASE + 2], P[BASE + 3]);   \
    unsigned b0 = cvtpk(P[BASE + 4], P[BASE + 5]), b1 = cvtpk(P[BASE + 6], P[BASE + 7]);                              \
    auto r0 = __builtin_amdgcn_permlane32_swap(a0, b0, false, false); auto r1 = __builtin_amdgcn_permlane32_swap(a1, b1, false, false); \
    u32x4 w = {r0[0], r1[0], r0[1], r1[1]}; OUT = *reinterpret_cast<bf16x8*>(&w); } while (0)
    PK4(p0, 0, pa0); PK4(p0, 8, pa1); PK4(p1, 0, pa2); PK4(p1, 8, pa3);
#undef PK4
}
__device__ __forceinline__ int v_st(int k, int c) { const int kk = (k & ~0xC) | ((k & 4) << 1) | ((k & 8) >> 1); return ((kk >> 3) * 4 + (c >> 5)) * 512 + ((kk & 7) * 32 + (c & 31)) * 2; }
__device__ __forceinline__ int v_rd_base(int lane) { return ((lane & 3) << 3) | (((lane >> 2) & 3) << 6) | (((lane >> 4) & 1) << 5) | (((lane >> 5) & 1) << 8); }
constexpr int v_rd_off(int d0, int ks, int half) { return d0 * 512 + ks * 4096 + half * 2048; }
template <int OFF> __device__ __forceinline__ s16x4 tr_read(int vb) {
    s16x4 r; asm volatile("ds_read_b64_tr_b16 %0, %1 offset:%2" : "=&v"(r) : "v"(vb), "i"(OFF) : "memory"); return r;
}
template <int D0> __device__ __forceinline__ void pv_one(f32x16& od, int vb, bf16x8 pa0, bf16x8 pa1, bf16x8 pa2, bf16x8 pa3) {
    const s16x4 l0 = tr_read<v_rd_off(D0, 0, 0)>(vb), h0 = tr_read<v_rd_off(D0, 0, 1)>(vb), l1 = tr_read<v_rd_off(D0, 1, 0)>(vb), h1 = tr_read<v_rd_off(D0, 1, 1)>(vb);
    const s16x4 l2 = tr_read<v_rd_off(D0, 2, 0)>(vb), h2 = tr_read<v_rd_off(D0, 2, 1)>(vb), l3 = tr_read<v_rd_off(D0, 3, 0)>(vb), h3 = tr_read<v_rd_off(D0, 3, 1)>(vb);
    asm volatile("s_waitcnt lgkmcnt(0)" ::: "memory"); SBAR();
#define PK(Lo, Hi) (bf16x8){Lo[0], Lo[1], Lo[2], Lo[3], Hi[0], Hi[1], Hi[2], Hi[3]}
    od = __builtin_amdgcn_mfma_f32_32x32x16_bf16(pa0, PK(l0, h0), od, 0, 0, 0);
    od = __builtin_amdgcn_mfma_f32_32x32x16_bf16(pa1, PK(l1, h1), od, 0, 0, 0);
    od = __builtin_amdgcn_mfma_f32_32x32x16_bf16(pa2, PK(l2, h2), od, 0, 0, 0);
    od = __builtin_amdgcn_mfma_f32_32x32x16_bf16(pa3, PK(l3, h3), od, 0, 0, 0);
#undef PK
}

template <int D0> __device__ __forceinline__ void pv_rd(s16x4 (&f)[8], int vb) {
    f[0] = tr_read<v_rd_off(D0, 0, 0)>(vb); f[1] = tr_read<v_rd_off(D0, 0, 1)>(vb); f[2] = tr_read<v_rd_off(D0, 1, 0)>(vb); f[3] = tr_read<v_rd_off(D0, 1, 1)>(vb);
    f[4] = tr_read<v_rd_off(D0, 2, 0)>(vb); f[5] = tr_read<v_rd_off(D0, 2, 1)>(vb); f[6] = tr_read<v_rd_off(D0, 3, 0)>(vb); f[7] = tr_read<v_rd_off(D0, 3, 1)>(vb);
}
__device__ __forceinline__ void pv_mm(f32x16& od, const s16x4 (&f)[8], bf16x8 pa0, bf16x8 pa1, bf16x8 pa2, bf16x8 pa3) {
#define PK(Lo, Hi) (bf16x8){Lo[0], Lo[1], Lo[2], Lo[3], Hi[0], Hi[1], Hi[2], Hi[3]}
    od = __builtin_amdgcn_mfma_f32_32x32x16_bf16(pa0, PK(f[0], f[1]), od, 0, 0, 0);
    od = __builtin_amdgcn_mfma_f32_32x32x16_bf16(pa1, PK(f[2], f[3]), od, 0, 0, 0);
    od = __builtin_amdgcn_mfma_f32_32x32x16_bf16(pa2, PK(f[4], f[5]), od, 0, 0, 0);
    od = __builtin_amdgcn_mfma_f32_32x32x16_bf16(pa3, PK(f[6], f[7]), od, 0, 0, 0);
#undef PK
}
__device__ __forceinline__ void pv_all(f32x16 (&o)[4], int vb, bf16x8 pa0, bf16x8 pa1, bf16x8 pa2, bf16x8 pa3) {
    s16x4 fa[8], fb[8];
    pv_rd<0>(fa, vb); pv_rd<1>(fb, vb);
    asm volatile("s_waitcnt lgkmcnt(8)" ::: "memory"); SBAR(); pv_mm(o[0], fa, pa0, pa1, pa2, pa3); SBAR();
    pv_rd<2>(fa, vb);
    asm volatile("s_waitcnt lgkmcnt(8)" ::: "memory"); SBAR(); pv_mm(o[1], fb, pa0, pa1, pa2, pa3); SBAR();
    pv_rd<3>(fb, vb);
    asm volatile("s_waitcnt lgkmcnt(8)" ::: "memory"); SBAR(); pv_mm(o[2], fa, pa0, pa1, pa2, pa3); SBAR();
    asm volatile("s_waitcnt lgkmcnt(0)" ::: "memory"); SBAR(); pv_mm(o[3], fb, pa0, pa1, pa2, pa3);
}
constexpr int OFFK_K = 0, OFFK_V = 4 * SHM_K, OFFK_WS = OFFK_V + 4 * SHM_V, OFFK_DN = OFFK_WS + 8 * 256;
__device__ __forceinline__ void attn_unit_k(const KA a, int L, int b, int h, int qbp, char* lds, float* stash, float lam, float lam_init, float smax_raw) {
    int tid_l = threadIdx.x; asm volatile("" : "+v"(tid_l));
    const int tid = tid_l, lane = tid & 63, r32 = lane & 31, hi = lane >> 5; const int wid = __builtin_amdgcn_readfirstlane(tid >> 6);
    const int grp = wid >> 2, wq = wid & 3, t256 = tid & 255;
    const bf16_t* z = (const bf16_t*)(a->ws + WS_Z); bf16_t* mix = (bf16_t*)(a->ws + WS_MIX);
    const bool pair = h < 2; const int step = pair ? 1 : 2;
    const int qb128 = pair ? 2 * qbp + grp : qbp;
    const size_t rb = (size_t)b * SEQ; const int q0 = qb128 * 128;
    const int NT = 2 * qb128 + 2, NI = pair ? 4 * qbp + 4 : qbp + 1, jmax = 2 * qb128 + (wq >> 1);
    const float slope = exp2f(-2.0f * (float)(h + 1));
    const float nb = -slope / SCALE;
    constexpr float C = SCALE * 1.4426950408889634f;
    char* K_lds = lds + OFFK_K + grp * SHM_K; char* V_lds = lds + OFFK_V + grp * SHM_V;
    float* wsf = (float*)(lds + OFFK_WS) + wid * 64; float* li_l = wsf; float* al_l = wsf + 32;
    unsigned* dn = (unsigned*)(lds + OFFK_DN);
    const int vb0 = (int)(uintptr_t)V_lds + v_rd_base(lane);
    int kso[2], vso[4];
#pragma unroll
    for (int i = 0; i < 2; ++i) { const int ci = (2 * wq + i) * 64 + lane, row = ci >> 3, sc_ = (ci & 7) ^ ((row >> 1) & 7); kso[i] = row * INW + sc_ * 8; }
#pragma unroll
    for (int i = 0; i < 4; ++i) { const int ci = (4 * wq + i) * 64 + lane, sub = ci >> 5, within = ci & 31; const int kk = (sub >> 2) * 8 + (within >> 2);
        const int k = (kk & ~0xC) | ((kk & 4) << 1) | ((kk & 8) >> 1); const int c_ = (sub & 3) * 32 + (within & 3) * 8; vso[i] = k * INW + c_; }
    const int qpos = q0 + wq * 32 + r32;
    f32x16 o[4];
    for (int c = 0; c < 2; ++c) {
        const bf16_t* Kg = z + rb * INW + ZK + h * 128 + c * 64;
        const bf16_t* Vg = z + rb * INW + ZV + h * 128;
        const bf16_t* Qw = z + (rb + qpos) * INW + h * 128 + c * 64 + hi * 8;
        bf16x8 qr[4];
#pragma unroll
        for (int d0 = 0; d0 < 4; ++d0) qr[d0] = *(const bf16x8*)(Qw + d0 * 16);
        float m_reg = -1e30f, l_reg = 0.f;
#pragma unroll
        for (int d = 0; d < 4; ++d) o[d] = f32x16{};
#define ATT_DMA(TILE, BUF) do { const size_t ro_ = (size_t)(TILE) * 64 * INW; \
            _Pragma("unroll") for (int i_ = 0; i_ < 2; ++i_) __builtin_amdgcn_global_load_lds((const unsigned*)(Kg + ro_ + kso[i_]), (LAS unsigned*)(K_lds + (BUF) * 2 * SHM_K + (2 * wq + i_) * 1024), 16, 0, 0); \
            _Pragma("unroll") for (int i_ = 0; i_ < 4; ++i_) __builtin_amdgcn_global_load_lds((const unsigned*)(Vg + ro_ + vso[i_]), (LAS unsigned*)(V_lds + (BUF) * 2 * SHM_V + (4 * wq + i_) * 1024), 16, 0, 0); } while (0)
        ATT_DMA(pair ? NT - 1 : NT - 2 + grp, 0);
        if (tid < 16) dn[tid] = 0u;
        bool done = false;
        for (int it = 0; it < NI; ++it) { const int J = pair ? NT - 1 - it : NT - 2 - 2 * it + grp, buf = it & 1;
            asm volatile("s_waitcnt vmcnt(0)" ::: "memory");
            if (lane == 0 && done) dn[buf * 8 + wid] = 1u;
            __syncthreads();
#ifndef ATT_NO_SKIP
            { const u32x4 d0v = *(const u32x4*)(dn + buf * 8), d1v = *(const u32x4*)(dn + buf * 8 + 4);
              if ((d0v.x & d0v.y & d0v.z & d0v.w & d1v.x & d1v.y & d1v.z & d1v.w) != 0u) break; }
#endif
            if (it + 1 < NI && J - step >= 0) ATT_DMA(J - step, buf ^ 1);
            if (J >= 0 && J <= jmax && !done) {
                f32x16 p0, p1;
                { const float dq = (float)(qpos - J * 64 - 4 * hi);
                  if (J < jmax) { const float base = nb * dq;
#pragma unroll
                      for (int r = 0; r < 16; ++r) { const float cr_ = (float)((r & 3) + 8 * (r >> 2)); p0[r] = fmaf(-cr_, nb, base); p1[r] = fmaf(-(cr_ + 32.f), nb, base); } }
                  else {
#pragma unroll
                      for (int r = 0; r < 16; ++r) { const float ar_ = dq - (float)((r & 3) + 8 * (r >> 2)); p0[r] = nb * fabsf(ar_); p1[r] = nb * fabsf(ar_ - 32.f); } } }
                const char* Ks = K_lds + buf * 2 * SHM_K;
                bf16x8 kf[8];
#pragma unroll
                for (int d0 = 0; d0 < 4; ++d0) { const int cb = (d0 * 16 + hi * 8) * 2; kf[2 * d0] = *(const bf16x8*)(Ks + KSWZ(r32, cb)); kf[2 * d0 + 1] = *(const bf16x8*)(Ks + KSWZ(32 + r32, cb)); }
#pragma unroll
                for (int d0 = 0; d0 < 4; ++d0) { asm volatile("" : "+v"(kf[2 * d0]), "+v"(kf[2 * d0 + 1]));
                    p0 = __builtin_amdgcn_mfma_f32_32x32x16_bf16(kf[2 * d0], qr[d0], p0, 0, 0, 0);
                    p1 = __builtin_amdgcn_mfma_f32_32x32x16_bf16(kf[2 * d0 + 1], qr[d0], p1, 0, 0, 0); }
                float alpha;
                partialSM(p0, p1, m_reg, alpha);
                if (__any(alpha < 1.f)) { if (hi == 0) al_l[r32] = alpha; asm volatile("s_waitcnt lgkmcnt(0)" ::: "memory");
#pragma unroll
                    for (int d = 0; d < 4; ++d)
#pragma unroll
                        for (int r = 0; r < 16; ++r) o[d][r] *= al_l[crow(r, hi)]; }
                bf16x8 pa0, pa1, pa2, pa3;
                finishSM(p0, p1, alpha, l_reg, pa0, pa1, pa2, pa3); SBAR();
                const int vb = vb0 + buf * 2 * SHM_V;
                pv_all(o, vb, pa0, pa1, pa2, pa3);
            }
#ifndef ATT_NO_SKIP
            if (!done) {
                float mmin = m_reg;
#pragma unroll
                for (int o_ = 1; o_ < 64; o_ <<= 1) mmin = fminf(mmin, __shfl_xor(mmin, o_));
                const float dmin = (float)(q0 + wq * 32 - ((J - step) * 64 + 63));
                done = (J - step < 0) || ((smax_raw + nb * dmin - mmin) * C < -32.0f);
            }
#endif
        }
#undef ATT_DMA
        __syncthreads();
        float* cmb = (float*)lds + wq * 4096;
        float* cml = (float*)(lds + 4 * 16384) + wq * 128;
        if (grp == 1 && !pair) {
#pragma unroll
            for (int d = 0; d < 4; ++d)
#pragma unroll
                for (int r = 0; r < 16; ++r) cmb[(d * 16 + r) * 64 + lane] = o[d][r];
            cml[lane] = m_reg; cml[64 + lane] = l_reg; }
        __syncthreads();
        if (grp == 0 && !pair) {
            const float mB = cml[lane], lB = cml[64 + lane]; const float mN = fmaxf(m_reg, mB);
            const float fA = __builtin_amdgcn_exp2f((m_reg - mN) * C), fB = __builtin_amdgcn_exp2f((mB - mN) * C);
            l_reg = l_reg * fA + lB * fB;
            if (hi == 0) { al_l[r32] = fA; li_l[r32] = fB; } asm volatile("s_waitcnt lgkmcnt(0)" ::: "memory");
            float fa[16], fb[16];
#pragma unroll
            for (int r = 0; r < 16; ++r) { fa[r] = al_l[crow(r, hi)]; fb[r] = li_l[crow(r, hi)]; }
#pragma unroll
            for (int d = 0; d < 4; ++d)
#pragma unroll
                for (int r = 0; r < 16; ++r) o[d][r] = o[d][r] * fa[r] + cmb[(d * 16 + r) * 64 + lane] * fb[r];
            asm volatile("s_waitcnt lgkmcnt(0)" ::: "memory");
        }
        if (grp == 0 || pair) {
            if (hi == 0) li_l[r32] = l_reg; asm volatile("s_waitcnt lgkmcnt(0)" ::: "memory");
            float rli[16];
#pragma unroll
            for (int r = 0; r < 16; ++r) rli[r] = __builtin_amdgcn_rcpf(li_l[crow(r, hi)]);
#pragma unroll
            for (int d = 0; d < 4; ++d)
#pragma unroll
                for (int r = 0; r < 16; ++r) o[d][r] *= rli[r];
            if (c == 0) {
                f32x4* sp = (f32x4*)(stash + tid * 64);
#pragma unroll
                for (int d = 0; d < 4; ++d)
#pragma unroll
                    for (int r4 = 0; r4 < 4; ++r4) sp[d * 4 + r4] = (f32x4){o[d][4 * r4], o[d][4 * r4 + 1], o[d][4 * r4 + 2], o[d][4 * r4 + 3]};
            }
        }
        asm volatile("s_waitcnt lgkmcnt(0)" ::: "memory");
        __syncthreads();
    }
    if (grp == 0 || pair) {
        { const f32x4* sp = (const f32x4*)(stash + tid * 64);
#pragma unroll
        for (int d = 0; d < 4; ++d)
#pragma unroll
            for (int r4 = 0; r4 < 4; ++r4) { const f32x4 sv = sp[d * 4 + r4];
#pragma unroll
                for (int e = 0; e < 4; ++e) o[d][4 * r4 + e] = sv[e] - lam * o[d][4 * r4 + e]; } }
        const float* og = a->in[10] + L * 128; const float osc = 1.0f - lam_init;
        float gn[4];
#pragma unroll
        for (int d = 0; d < 4; ++d) gn[d] = og[d * 32 + r32] * osc;
#pragma unroll
        for (int r = 0; r < 16; ++r) { float s = (o[0][r] * o[0][r] + o[1][r] * o[1][r]) + (o[2][r] * o[2][r] + o[3][r] * o[3][r]);
            s += __shfl_xor(s, 1); s += __shfl_xor(s, 2); s += __shfl_xor(s, 4); s += __shfl_xor(s, 8); s += __shfl_xor(s, 16);
            const float rs = __builtin_amdgcn_rsqf(s * (1.0f / 128.0f) + EPS);
            bf16_t* orow = mix + (rb + q0 + wq * 32 + crow(r, hi)) * DM + h * 128 + r32;
#pragma unroll
            for (int d = 0; d < 4; ++d) { const unsigned w = cvtpk(o[d][r] * rs * gn[d], 0.f); orow[d * 32] = (bf16_t)(w & 0xffffu); } }
    }
}
#undef KSWZ
#undef SBAR
}

#define GAS __attribute__((address_space(1)))
#define XB_TMO      128
#define XB_XCNT(j)  (256  + 64 * (j))
#define XB_XSUB(j)  (1280 + 64 * (j))
#define XB_XGEN(j)  (2304 + 64 * (j))
#define XB_TOP      3328
#define XB_TOPGEN   3392
#define XCD_BAR_WORDS 3456
#define XB_SPIN_CAP (1u << 18)

__device__ __forceinline__ unsigned xb_ld(unsigned* p)              { return __hip_atomic_load(p, __ATOMIC_RELAXED, __HIP_MEMORY_SCOPE_AGENT); }
__device__ __forceinline__ unsigned xb_add(unsigned* p, unsigned v) { return __hip_atomic_fetch_add(p, v, __ATOMIC_RELAXED, __HIP_MEMORY_SCOPE_AGENT); }
__device__ __forceinline__ unsigned xb_xcc_id() { return (unsigned)__builtin_amdgcn_s_getreg((3 << 11) | 20) & 0xFu; }
#define XB_SPIN(cond, bar) do { unsigned _sp = 0; while (cond) { __builtin_amdgcn_s_sleep(1); \
    if ((++_sp & 255u) == 0u) { if (xb_ld(&(bar)[XB_TMO])) break; if (_sp > XB_SPIN_CAP) { atomicAdd(&(bar)[XB_TMO], 1u); break; } } } } while (0)

struct XcdBarrier {
    unsigned* bar; unsigned x;
    volatile LAS unsigned* st;
};

__device__ __forceinline__ XcdBarrier xcd_barrier_post(unsigned* bar, volatile LAS unsigned* st) {
    XcdBarrier b; b.bar = bar; b.x = xb_xcc_id(); b.st = st;
    if (threadIdx.x == 0) (void)xb_add(&bar[XB_XCNT(b.x)], 1u);
    return b;
}
__device__ __forceinline__ void xcd_barrier_complete(unsigned* bar, unsigned x, unsigned& nloc, unsigned& nx) {
    const unsigned G = gridDim.x * gridDim.y * gridDim.z;
    unsigned sum, cnt, mine, sp = 0u;
    for (;;) {
        sum = 0u; cnt = 0u; mine = 0u;
#pragma unroll
        for (unsigned j = 0; j < 16; ++j) { const unsigned c = xb_ld(&bar[XB_XCNT(j)]); sum += c; cnt += (c > 0u) ? 1u : 0u; mine = (j == x) ? c : mine; }
        if (sum == G) break;
        __builtin_amdgcn_s_sleep(1);
        if ((++sp & 255u) == 0u) { if (xb_ld(&bar[XB_TMO])) break; if (sp > XB_SPIN_CAP) { atomicAdd(&bar[XB_TMO], 1u); break; } }
    }
    nloc = mine > 0u ? mine : 1u; nx = cnt > 0u ? cnt : 1u;
}

__device__ __forceinline__ void xcd_barrier(const XcdBarrier& b) {
    asm volatile("s_waitcnt vmcnt(0)" ::: "memory");
    __syncthreads();
    if (threadIdx.x == 0) {
        unsigned* bar = b.bar;
        __builtin_amdgcn_s_waitcnt(0);
        unsigned nloc = b.st[0], nx = b.st[1];
        if (nloc == 0u) { xcd_barrier_complete(bar, b.x, nloc, nx); b.st[0] = nloc; b.st[1] = nx; }
        const unsigned old = xb_add(&bar[XB_XSUB(b.x)], 1u);
        const unsigned gen = old / nloc;
        if (old + 1u == (gen + 1u) * nloc) {
            __builtin_amdgcn_fence(__ATOMIC_RELEASE, "agent");
            asm volatile("s_waitcnt vmcnt(0)" ::: "memory");
            const unsigned og = xb_add(&bar[XB_TOP], 1u);
            const unsigned tg = og / nx;
            if (og + 1u == (tg + 1u) * nx) xb_add(&bar[XB_TOPGEN], 1u);
            else XB_SPIN(xb_ld(&bar[XB_TOPGEN]) == tg, bar);
            __builtin_amdgcn_fence(__ATOMIC_ACQUIRE, "agent");
            xb_add(&bar[XB_XGEN(b.x)], 1u);
            asm volatile("s_waitcnt vmcnt(0)" ::: "memory");
        } else {
            XB_SPIN(xb_ld(&bar[XB_XGEN(b.x)]) == gen, bar);
            __builtin_amdgcn_fence(__ATOMIC_ACQUIRE, "agent");
            asm volatile("s_waitcnt vmcnt(0)" ::: "memory");
        }
    }
    __syncthreads();
}


struct OneUnit { int pm;
    __device__ __forceinline__ bool next(int i, pg8::Unit& u) const { if (i != 0) return false; u.pm = pm; u.pn = 0; return true; }
    __device__ __forceinline__ void a_ready(const pg8::Unit&) const {}
    __device__ __forceinline__ void done(const pg8::Unit&) const {} };
__global__ void __launch_bounds__(NTHREADS) mega(Args a_unused) {
    KA a; a.p = (const __attribute__((address_space(4))) Args*)__builtin_amdgcn_kernarg_segment_ptr();
    extern __shared__ __attribute__((aligned(16))) unsigned char lds[];
    cg::grid_group grid = cg::this_grid();
    const int G = gridDim.x, bx = blockIdx.x;
    const int vcu = (G % 8 == 0) ? (bx % 8) * (G / 8) + bx / 8 : bx;
    bf16_t* const XN = (bf16_t*)(a->ws + WS_XN); bf16_t* const Z = (bf16_t*)(a->ws + WS_Z); bf16_t* const MIX = (bf16_t*)(a->ws + WS_MIX);
    bf16_t* const YG = (bf16_t*)(a->ws + WS_YG); bf16_t* const HID = (bf16_t*)(a->ws + WS_HID); bf16_t* const PP = (bf16_t*)(a->ws + WS_PP); bf16_t* const PBF = (bf16_t*)(a->ws + WS_PBF);
    float* const SSQA = (float*)(a->ws + WS_SSQA); float* const SSQB = (float*)(a->ws + WS_SSQB); float* const SSQC = (float*)(a->ws + WS_SSQC);
    PG8_LAS unsigned char* ldsl = (PG8_LAS unsigned char*)lds;
    volatile LAS unsigned* MISC = (volatile LAS unsigned*)(ldsl + LDS_BYTES - 64);
    if (threadIdx.x < 2) MISC[threadIdx.x] = 0u;
    __syncthreads();
    XcdBarrier xbar = xcd_barrier_post((unsigned*)a->ws, MISC);
    const int ph_lo = a->ph_lo, ph_hi = a->ph_hi;
    for (int ph = ph_lo; ph < ph_hi; ++ph) {
        asm volatile("" : "+s"(a.p));
        if (ph == 0) {
#ifndef NO_PRO
 prologue_phase(a, lds, bx, G);
#endif
 pcvt_rows(a, 0, bx * (MT / 256), MT / 256); __syncthreads(); }
        else {
            const int L = (ph - 1) / 6, kk6 = (ph - 1) % 6, k = kk6 < 2 ? kk6 : kk6 + 1;
            const bf16_t* wl = (const bf16_t*)(a->ws + WS_W) + (size_t)L * LW_ELEMS;
#ifndef NO_GOUT
            if (k == 0 || k == 4) {
                bf16_t* const XN2 = (bf16_t*)(a->ws + WS_XN2);
                const int npass = (k == 0 && bx >= G / 2) ? 2 : 1;
                for (int pass = 0; pass < npass; ++pass) {
                    pg8::Gemm g; pg8::EpiOut E; pg8::StaticOrder S;
                    if (k == 0 && pass == 0) { g = pg8::Gemm{L == 0 ? XN : XN2, wl + LW_IN, MT, INW, DM};   E = pg8::EpiOut{Z, INW, SSQA, 0, a->in[4] + L * 64, a->in[5] + L * 64}; S.init(g.M, g.N, G, bx); }
                    else if (k == 0)         { g = pg8::Gemm{PBF, wl + LW_PLE, MT, DM, PLEW}; E = pg8::EpiOut{PP, DM, nullptr, 0, nullptr, nullptr}; S.init(g.M, g.N, G / 2, bx - G / 2); }
                    else                     { g = pg8::Gemm{XN, wl + LW_FF1, MT, FFW, DM};  E = pg8::EpiOut{HID, FFW, SSQB, 2, nullptr, nullptr}; S.init(g.M, g.N, G, bx); }
                    pg8::gemm_phase<pg8::EpiOut, pg8::StaticOrder, true, true>(ldsl, g, S, E);
                }
            }
#endif
#ifndef NO_GRES
            if (k == 3 || k == 5 || k == 6) {
                pg8::Gemm g; pg8::EpiResid E;
                if (k == 3)      { g = pg8::Gemm{MIX, wl + LW_OUT, MT, DM, DM};  E = pg8::EpiResid{L == 0 ? a->in[0] : a->out, a->out, XN, SSQB, nullptr, nullptr, 0}; }
                else if (k == 5) { g = pg8::Gemm{HID, wl + LW_FF2, MT, DM, FFW}; E = pg8::EpiResid{a->out, a->out, XN, SSQC, nullptr, nullptr, 0}; }
                else             { g = pg8::Gemm{XN, wl + LW_GATE, MT, DM, DM};  E = pg8::EpiResid{a->out, a->out, (bf16_t*)(a->ws + WS_XN2), SSQA, SSQC, PP, 1}; }
                pg8::StaticOrder S; S.init(g.M, g.N, G, bx);
                pg8::gemm_phase<pg8::EpiResid, pg8::StaticOrder, true, true>(ldsl, g, S, E);
                if (k == 3 && L + 1 < DEPTH) pcvt_rows(a, L + 1, bx * (MT / 256), MT / 256);
            }
#endif
            if (k == 1) {
                float* stash = (float*)(a->ws + WS_STASH) + (size_t)bx * 64 * NTHREADS;
                unsigned* qbase = (unsigned*)(a->ws + 14336) + (size_t)L * 8 * 16;
                volatile LAS unsigned* qs = (volatile LAS unsigned*)(ldsl + LDS_BYTES - 32);
                const unsigned myq = xb_xcc_id() & 7u;
                const float lam_init = 0.8f - 0.6f * __expf(-0.3f * (float)L);
                float lam, smax_raw;
                { const int lane = threadIdx.x & 63;
                  const float v1 = wave_sum(a->in[6][L * 64 + lane] * a->in[7][L * 64 + lane]), v2 = wave_sum(a->in[8][L * 64 + lane] * a->in[9][L * 64 + lane]); lam = expf(v1) - expf(v2) + lam_init;
                  float gq = fabsf(a->in[4][L * 64 + lane]), gk = fabsf(a->in[5][L * 64 + lane]);
#pragma unroll
                  for (int o = 1; o < 64; o <<= 1) { gq = fmaxf(gq, __shfl_xor(gq, o)); gk = fmaxf(gk, __shfl_xor(gk, o)); }
                  smax_raw = 64.0f * gq * gk * 1.03f; }
                for (unsigned qo = 0; qo < 8u; ++qo) { const unsigned q = (myq + qo) & 7u;
                    bool pub = false;
                    for (;;) {
                        if (pub) asm volatile("s_waitcnt vmcnt(0)" ::: "memory");
                        if (threadIdx.x == 0) qs[0] = __hip_atomic_fetch_add(qbase + q * 16, 1u, __ATOMIC_RELAXED, __HIP_MEMORY_SCOPE_AGENT);
                        __syncthreads();
                        const unsigned idx = qs[0];
                        if (pub && threadIdx.x == 0) __hip_atomic_fetch_add(qbase + q * 16 + 1, 1u, __ATOMIC_RELAXED, __HIP_MEMORY_SCOPE_AGENT);
                        pub = (idx >= 32u && idx < 48u);
                        if (idx >= 112u && idx < 128u && threadIdx.x == 0) {
                            unsigned sp = 0;
                            while (__hip_atomic_load(qbase + q * 16 + 1, __ATOMIC_RELAXED, __HIP_MEMORY_SCOPE_AGENT) < 16u) { __builtin_amdgcn_s_sleep(8); if (++sp > (1u << 20)) break; }
                            __builtin_amdgcn_fence(__ATOMIC_ACQUIRE, "agent"); asm volatile("s_waitcnt vmcnt(0)" ::: "memory"); }
                        __syncthreads();
                        if (idx >= 256u) break;
                        if (idx >= 32u && idx < 48u) ssm_unit(a, L, (int)(q * 16u + (idx - 32u)), lds);
                        else if (idx < 112u) { const unsigned ja = idx < 32u ? idx : idx - 16u;
                            const int hh = ja < 64u ? 3 - (int)(ja & 1u) : 1 - (int)((ja - 64u) & 1u), qq = ja < 64u ? 31 - (int)(ja >> 1) : 15 - (int)((ja - 64u) >> 1);
                            att::attn_unit_k(a, L, (int)q, hh, qq, (char*)lds, stash, lam, lam_init, smax_raw); }
                        else if (idx < 128u) {
                            int kglu = SSW; asm volatile("" : "+s"(kglu));
                            pg8::Gemm g{YG, wl + LW_GLU, MT, SSW, kglu}; pg8::EpiGlu E{YG, a->in[24] + L * SSW, MIX};
                            OneUnit S; S.pm = (int)(q * 16u + (idx - 112u));
                            pg8::gemm_phase<pg8::EpiGlu, OneUnit, true, true>(ldsl, g, S, E);
                        }
                        else conv_unit(a, L, (int)(q * 128u + (idx - 128u)), lds);
                    } }
            }
        }
        if (ph + 1 < ph_hi)
        { if (ph_hi < 0) grid.sync(); else xcd_barrier(xbar); }
    }
}

#ifndef N_LAUNCH_MODE
#define N_LAUNCH_MODE 1
#endif
extern "C" void kernel_launch(void* const* d_in, const int* in_sizes, int n_in, void* d_out, int out_size, void* d_ws, size_t ws_size, hipStream_t stream) {
    static int grid = 0;
    if (grid == 0) {
        if (n_in != 32 || in_sizes[0] != MT * DM || out_size != MT * DM || ws_size < WS_END) {
            fprintf(stderr, "kernel_launch: shape mismatch n_in %d in0 %d out %d ws %zu (need %zu)\n", n_in, n_in > 0 ? in_sizes[0] : -1, out_size, ws_size, (size_t)WS_END); grid = -1; return; }
        int dev = 0, cus = 0, per_cu = 0;
        hipGetDevice(&dev); hipDeviceGetAttribute(&cus, hipDeviceAttributeMultiprocessorCount, dev);
        if (hipFuncSetAttribute((const void*)mega, hipFuncAttributeMaxDynamicSharedMemorySize, LDS_BYTES) != hipSuccess) { fprintf(stderr, "kernel_launch: hipFuncSetAttribute failed\n"); grid = -1; return; }
        hipOccupancyMaxActiveBlocksPerMultiprocessor(&per_cu, (const void*)mega, NTHREADS, LDS_BYTES);
        (void)hipGetLastError();
        grid = cus * (per_cu < 1 ? 1 : per_cu);
        if (grid != 256) { fprintf(stderr, "kernel_launch: grid %d (cus %d per_cu %d): this kernel is built for 256\n", grid, cus, per_cu); if (grid > 256) grid = 256; }
    }
    if (grid < 0) return;
    if (hipMemsetAsync(d_ws, 0, 16384, stream) != hipSuccess) { fprintf(stderr, "kernel_launch: memset failed\n"); return; }
    Args a{};
    for (int i = 0; i < 32; ++i) a.in[i] = (const float*)d_in[i];
    a.out = (float*)d_out; a.ws = (unsigned char*)d_ws;
    constexpr int NPH = 1 + 6 * DEPTH;
#if N_LAUNCH_MODE == 1
    a.ph_lo = 0; a.ph_hi = NPH;
    void* args[] = {&a};
    hipError_t e = hipLaunchCooperativeKernel((const void*)mega, dim3(grid), dim3(NTHREADS), args, LDS_BYTES, stream);
    if (e != hipSuccess) fprintf(stderr, "kernel_launch: cooperative launch failed: %s (grid %d)\n", hipGetErrorString(e), grid);
#else
    for (int ph = 0; ph < NPH; ++ph) { a.ph_lo = ph; a.ph_hi = ph + 1; hipLaunchKernelGGL(mega, dim3(grid), dim3(NTHREADS), LDS_BYTES, stream, a); }
#endif
}
```

```cpp
#include <hip/hip_runtime.h>
#include <hip/hip_cooperative_groups.h>
#include <cstdio>
#include <cstdint>
namespace cg = cooperative_groups;
namespace pg8 {
#define PG8_LAS __attribute__((address_space(3)))
typedef unsigned short bf16_t;
typedef short bf16x8 __attribute__((ext_vector_type(8)));
typedef float f32x4 __attribute__((ext_vector_type(4)));
typedef unsigned u32x4 __attribute__((ext_vector_type(4)));
constexpr int BM = 256, BK = 64, HALF = 128, HTB = HALF * BK * 2  , STAGE_BYTES = 8 * HTB, NXCD = 8, WGM = 8;

__host__ __device__ __forceinline__ int lds_byte(int r, int c) { const int st = (r >> 4) * 2 + (c >> 5), rr = r & 15, cc = c & 31, ob = rr * 64 + cc * 2; return st * 1024 + (ob ^ (((ob >> 9) & 1) << 5)); }
__host__ __device__ __forceinline__ void stage_rc(int b, int& R, int& C) { const int st = b / 1024, sb = b % 1024, swz = sb ^ (((sb >> 9) & 1) << 5); R = (st >> 1) * 16 + swz / 64; C = (st & 1) * 32 + (swz % 64) / 2; }
__host__ __device__ __forceinline__ int perm32(int rho) { const int n = rho >> 4, i = rho & 15; return 8 * (i >> 2) + 4 * n + (i & 3); }

struct Unit { int pm, pn; };
struct Gemm { const bf16_t* A; const bf16_t* Bt; int M, N, K; };

struct StaticOrder {
    int nM, nN, nwg, G, c;
    __host__ __device__ void init(int M, int N, int G_, int c_) { nM = M / BM; nN = N / BM; nwg = nM * nN; G = G_; c = c_; }
    __host__ __device__ bool next(int i, Unit& u) const {
        const long L = (long)i * G + c; if (L >= nwg) return false;
        int wgid = (int)L; { const int q = nwg / NXCD, r = nwg % NXCD, xcd = wgid % NXCD, off = wgid / NXCD; wgid = (xcd < r ? xcd * (q + 1) : r * (q + 1) + (xcd - r) * q) + off; }
        const int nig = WGM * nN, gid = wgid / nig, fm = gid * WGM, gsz = (nM - fm) < WGM ? (nM - fm) : WGM;
        u.pm = fm + ((wgid % nig) % gsz); u.pn = (wgid % nig) / gsz; return true;
    }
    __device__ __forceinline__ void a_ready(const Unit&) const {}
    __device__ __forceinline__ void done(const Unit&) const {}
};

typedef float f32x2_cv __attribute__((ext_vector_type(2))); typedef __bf16 bf16x2_cv __attribute__((ext_vector_type(2)));
__device__ __forceinline__ unsigned cvt_pk_bf16(float lo, float hi) { const f32x2_cv v = {lo, hi}; const bf16x2_cv b = __builtin_convertvector(v, bf16x2_cv); return __builtin_bit_cast(unsigned, b); }
typedef unsigned u32x2v __attribute__((ext_vector_type(2)));
__device__ __forceinline__ float bf_lo(unsigned w) { return __uint_as_float(w << 16); }
__device__ __forceinline__ float bf_hi(unsigned w) { return __uint_as_float(w & 0xffff0000u); }
__device__ __forceinline__ float sigmoidf_(float x) { return __builtin_amdgcn_rcpf(1.0f + __expf(-x)); }
__device__ __forceinline__ float row_rstd(const float* ssq, int row) {
    const f32x4* p = (const f32x4*)(ssq + (size_t)row * 16);
    const f32x4 a = p[0], b = p[1], c = p[2], d = p[3];
    const float s = ((a[0] + a[1]) + (a[2] + a[3])) + ((b[0] + b[1]) + (b[2] + b[3])) + ((c[0] + c[1]) + (c[2] + c[3])) + ((d[0] + d[1]) + (d[2] + d[3]));
    return rsqrtf(s * (1.0f / 1024.0f) + 1e-6f);
}
struct EpiOut {
    static constexpr bool PERM = true, AFTER_DRAIN = false;
    bf16_t* O; int ldc; const float* ssq; int act; const float* qg; const float* kg;
    __device__ __forceinline__ void operator()(const f32x4 (&acc)[2][2][4][2], const Unit& u, int wr, int wc, int fr, int fq) const {
        const int row0 = u.pm * BM + wr * 64 + fr; const bool win = qg != nullptr; const bool qkn = win && u.pn < 4;
        const int colb0 = win ? u.pn * BM + wc * 64 + 8 * fq : u.pn * BM + wc * 32 + 8 * fq; const int bjs = win ? 32 : HALF;
        f32x4 gn[2][2];
        if (qkn) { const float* gp = (u.pn < 2 ? qg : kg) + 8 * fq;
#pragma unroll
            for (int bj = 0; bj < 2; ++bj) { gn[bj][0] = *(const f32x4*)(gp + 32 * bj); gn[bj][1] = *(const f32x4*)(gp + 32 * bj + 4); } }
        f32x4 pr[2][4];
        if (ssq) {
#pragma unroll
            for (int ai = 0; ai < 2; ++ai)
#pragma unroll
                for (int m = 0; m < 4; ++m) pr[ai][m] = *(const f32x4*)(ssq + (size_t)(row0 + ai * HALF + m * 16) * 16 + 4 * fq); }
#pragma unroll
        for (int ai = 0; ai < 2; ++ai)
#pragma unroll
            for (int m = 0; m < 4; ++m) { const int row = row0 + ai * HALF + m * 16; float sc = 1.0f;
                if (ssq) { float t = (pr[ai][m][0] + pr[ai][m][1]) + (pr[ai][m][2] + pr[ai][m][3]); t += __shfl_xor(t, 16); t += __shfl_xor(t, 32); sc = rsqrtf(t * (1.0f / 1024.0f) + 1e-6f); }
                bf16_t* rowp = O + (size_t)row * ldc + colb0;
                f32x4 v[2][2];
#pragma unroll
                for (int bj = 0; bj < 2; ++bj) { v[bj][0] = acc[ai][bj][m][0] * sc; v[bj][1] = acc[ai][bj][m][1] * sc; }
                if (qkn) { float s = 0.f;
#pragma unroll
                    for (int bj = 0; bj < 2; ++bj)
#pragma unroll
                        for (int n = 0; n < 2; ++n) s += (v[bj][n][0] * v[bj][n][0] + v[bj][n][1] * v[bj][n][1]) + (v[bj][n][2] * v[bj][n][2] + v[bj][n][3] * v[bj][n][3]);
                    s += __shfl_xor(s, 16); s += __shfl_xor(s, 32);
                    const float rs = rsqrtf(s * (1.0f / 64.0f) + 1e-6f);
#pragma unroll
                    for (int bj = 0; bj < 2; ++bj) { v[bj][0] = v[bj][0] * rs * gn[bj][0]; v[bj][1] = v[bj][1] * rs * gn[bj][1]; } }
#pragma unroll
                for (int bj = 0; bj < 2; ++bj) { f32x4 v0 = v[bj][0], v1 = v[bj][1];
                    if (act == 2) {
#pragma unroll
                        for (int e = 0; e < 4; ++e) { const float a = fmaxf(v0[e], 0.f), b = fmaxf(v1[e], 0.f); v0[e] = a * a; v1[e] = b * b; } }
                    u32x4 w; w.x = cvt_pk_bf16(v0[0], v0[1]); w.y = cvt_pk_bf16(v0[2], v0[3]); w.z = cvt_pk_bf16(v1[0], v1[1]); w.w = cvt_pk_bf16(v1[2], v1[3]);
                    *(u32x4*)(rowp + bj * bjs) = w; } }
    }
};
struct EpiResid {
    static constexpr bool PERM = true, AFTER_DRAIN = false;
    const float* hin; float* h; bf16_t* xn; float* ssq_out; const float* ssq_in; const bf16_t* pp; int gated;
    __device__ __forceinline__ void operator()(const f32x4 (&acc)[2][2][4][2], const Unit& u, int wr, int wc, int fr, int fq) const {
        const int row0 = u.pm * BM + wr * 64 + fr; const int col0 = u.pn * BM + wc * 32 + 8 * fq;
        f32x4 hn[2][2]; u32x4 pn_[2]; f32x4 qn_ = (f32x4){0.f, 0.f, 0.f, 0.f};
#define PG8_RES_LOAD(IT) do { const size_t roff_ = (size_t)(row0 + ((IT) >> 2) * HALF + ((IT) & 3) * 16) * 1024 + col0; \
        _Pragma("unroll") for (int bj = 0; bj < 2; ++bj) { hn[bj][0] = *(const f32x4*)(hin + roff_ + bj * HALF); hn[bj][1] = *(const f32x4*)(hin + roff_ + bj * HALF + 4); \
            if (gated) pn_[bj] = *(const u32x4*)(pp + roff_ + bj * HALF); } \
        if (gated) qn_ = *(const f32x4*)(ssq_in + (size_t)(row0 + ((IT) >> 2) * HALF + ((IT) & 3) * 16) * 16 + 4 * fq); } while (0)
        PG8_RES_LOAD(0);
#pragma unroll
        for (int it = 0; it < 8; ++it) { const int ai = it >> 2, m = it & 3; const int row = row0 + ai * HALF + m * 16;
            f32x4 hc[2][2]; u32x4 pc[2];
#pragma unroll
            for (int bj = 0; bj < 2; ++bj) { hc[bj][0] = hn[bj][0]; hc[bj][1] = hn[bj][1]; pc[bj] = pn_[bj]; }
            const f32x4 qc = qn_;
            if (it < 7) PG8_RES_LOAD(it + 1);
            asm volatile("" ::: "memory");
            float rs = 1.0f;
            if (gated) { float t = (qc[0] + qc[1]) + (qc[2] + qc[3]); t += __shfl_xor(t, 16); t += __shfl_xor(t, 32); rs = rsqrtf(t * (1.0f / 1024.0f) + 1e-6f); }
            float s = 0.f; const size_t roff = (size_t)row * 1024 + col0;
#pragma unroll
            for (int bj = 0; bj < 2; ++bj) { const size_t off = roff + bj * HALF;
                f32x4 a0 = acc[ai][bj][m][0], a1 = acc[ai][bj][m][1];
                if (gated) { const u32x4 pw = pc[bj];
                    a0[0] = sigmoidf_(a0[0] * rs) * bf_lo(pw.x); a0[1] = sigmoidf_(a0[1] * rs) * bf_hi(pw.x); a0[2] = sigmoidf_(a0[2] * rs) * bf_lo(pw.y); a0[3] = sigmoidf_(a0[3] * rs) * bf_hi(pw.y);
                    a1[0] = sigmoidf_(a1[0] * rs) * bf_lo(pw.z); a1[1] = sigmoidf_(a1[1] * rs) * bf_hi(pw.z); a1[2] = sigmoidf_(a1[2] * rs) * bf_lo(pw.w); a1[3] = sigmoidf_(a1[3] * rs) * bf_hi(pw.w); }
                const f32x4 h0 = hc[bj][0] + a0, h1 = hc[bj][1] + a1;
                *(f32x4*)(h + off) = h0; *(f32x4*)(h + off + 4) = h1;
                s += ((h0[0] * h0[0] + h0[1] * h0[1]) + (h0[2] * h0[2] + h0[3] * h0[3])) + ((h1[0] * h1[0] + h1[1] * h1[1]) + (h1[2] * h1[2] + h1[3] * h1[3]));
                u32x4 w; w.x = cvt_pk_bf16(h0[0], h0[1]); w.y = cvt_pk_bf16(h0[2], h0[3]); w.z = cvt_pk_bf16(h1[0], h1[1]); w.w = cvt_pk_bf16(h1[2], h1[3]);
                *(u32x4*)(xn + off) = w; }
            s += __shfl_xor(s, 16); s += __shfl_xor(s, 32);
            if (fq == 0) ssq_out[(size_t)row * 16 + u.pn * 4 + wc] = s; }
#undef PG8_RES_LOAD
    }
};
struct EpiGlu {
    static constexpr bool PERM = true, AFTER_DRAIN = false;
    const bf16_t* yg; const float* bias; bf16_t* mix;
    __device__ __forceinline__ void operator()(const f32x4 (&acc)[2][2][4][2], const Unit& u, int wr, int wc, int fr, int fq) const {
        const int row0 = u.pm * BM + wr * 64 + fr; const int col0 = u.pn * BM + wc * 32 + 8 * fq;
#pragma unroll
        for (int bj = 0; bj < 2; ++bj) { const int c = col0 + bj * HALF;
            const f32x4 b0 = *(const f32x4*)(bias + c), b1 = *(const f32x4*)(bias + c + 4);
#pragma unroll
            for (int ai = 0; ai < 2; ++ai)
#pragma unroll
                for (int m = 0; m < 4; ++m) { const int row = row0 + ai * HALF + m * 16; asm volatile("" ::: "memory");
                    const u32x4 yw = *(const u32x4*)(yg + (size_t)row * 256 + c);
                    const f32x4 v0 = acc[ai][bj][m][0] + b0, v1 = acc[ai][bj][m][1] + b1;
                    u32x4 w;
                    w.x = cvt_pk_bf16(bf_lo(yw.x) * sigmoidf_(v0[0]), bf_hi(yw.x) * sigmoidf_(v0[1]));
                    w.y = cvt_pk_bf16(bf_lo(yw.y) * sigmoidf_(v0[2]), bf_hi(yw.y) * sigmoidf_(v0[3]));
                    w.z = cvt_pk_bf16(bf_lo(yw.z) * sigmoidf_(v1[0]), bf_hi(yw.z) * sigmoidf_(v1[1]));
                    w.w = cvt_pk_bf16(bf_lo(yw.w) * sigmoidf_(v1[2]), bf_hi(yw.w) * sigmoidf_(v1[3]));
                    *(u32x4*)(mix + (size_t)row * 1024 + 768 + c) = w; } }
    }
};
template <class Epi, class Sched, bool ALIGN_EPI = false, bool SP2 = false>
__device__ __forceinline__ void gemm_phase(PG8_LAS unsigned char* lds, const Gemm g, const Sched& S, const Epi& E) {
    int tid_l = threadIdx.x; asm volatile("" : "+v"(tid_l));
    const int tid = tid_l, wid = __builtin_amdgcn_readfirstlane(tid >> 6), lane = tid & 63, wr = wid >> 2, wc = wid & 3, fr = lane & 15, fq = lane >> 4;
    const int K = g.K, nt = K / BK;
    unsigned voffA[2], voffB[2];
#pragma unroll
    for (int i = 0; i < 2; ++i) { int R, C; stage_rc(tid * 16 + i * 8192, R, C); const int Rb = Epi::PERM ? ((R & ~31) + perm32(R & 31)) : R;
        voffA[i] = (unsigned)(R * K + C) * 2u; voffB[i] = (unsigned)(Rb * K + C) * 2u; }
    const size_t kstep = (size_t)(BK * 2);
    const size_t hstep = (size_t)HALF * K * 2;
    const size_t tstep = 2 * hstep;
    const unsigned ldsw = (unsigned)wid * 1024u;
    const int aoff = lds_byte(wr * 64 + fr, fq * 8), boff = lds_byte(wc * 32 + fr, fq * 8);
#define PG8_SA(b, h) (((b) * 2 + (h)) * HTB)
#define PG8_SB(b, h) ((4 + (b) * 2 + (h)) * HTB)
#define PG8_STAGE(bufoff, gbase, voff) do { _Pragma("unroll") for (int _i = 0; _i < 2; ++_i) \
        __builtin_amdgcn_global_load_lds((const unsigned*)((const char*)(gbase) + (voff)[_i]), (PG8_LAS unsigned*)(lds + (bufoff) + ldsw + _i * 8192), 16, 0, 0); } while (0)
#define PG8_LDA(dst, b, h) do { _Pragma("unroll") for (int m = 0; m < 4; ++m) _Pragma("unroll") for (int k = 0; k < 2; ++k) dst[m][k] = *(const PG8_LAS bf16x8*)(lds + PG8_SA(b, h) + aoff + m * 2048 + k * 1024); } while (0)
#define PG8_LDB(dst, b, h) do { _Pragma("unroll") for (int n = 0; n < 2; ++n) _Pragma("unroll") for (int k = 0; k < 2; ++k) dst[n][k] = *(const PG8_LAS bf16x8*)(lds + PG8_SB(b, h) + boff + n * 2048 + k * 1024); } while (0)
#define PG8_MMA(ai, bj, At, Bt) do { __builtin_amdgcn_s_setprio(1); _Pragma("unroll") for (int m = 0; m < 4; ++m) _Pragma("unroll") for (int n = 0; n < 2; ++n) _Pragma("unroll") for (int k = 0; k < 2; ++k) \
        acc[ai][bj][m][n] = __builtin_amdgcn_mfma_f32_16x16x32_bf16(Bt[n][k], At[m][k], acc[ai][bj][m][n], 0, 0, 0); __builtin_amdgcn_s_setprio(0); } while (0)
#define PG8_WAIT_V(n) asm volatile("s_waitcnt vmcnt(" #n ")" ::: "memory")
#define PG8_WAIT_L(n) asm volatile("s_waitcnt lgkmcnt(" #n ")" ::: "memory")
#define PG8_BAR __builtin_amdgcn_s_barrier()
#define PG8_SCHED __builtin_amdgcn_sched_barrier(0)
    Unit cur, nxt; int ui = 0;
    if (!S.next(0, cur)) return;
    f32x4 acc[2][2][4][2];
#pragma unroll
    for (int a = 0; a < 2; ++a)
#pragma unroll
        for (int b = 0; b < 2; ++b)
#pragma unroll
            for (int m = 0; m < 4; ++m)
#pragma unroll
                for (int n = 0; n < 2; ++n) acc[a][b][m][n] = (f32x4){0.f, 0.f, 0.f, 0.f};
    bf16x8 At[4][2], B0[2][2], B1[2][2];
    const char* cA = (const char*)g.A + (size_t)cur.pm * tstep; const char* cB = (const char*)g.Bt + (size_t)cur.pn * tstep;
    S.a_ready(cur);
    if constexpr (SP2) {
        PG8_STAGE(PG8_SB(0, 0), cB, voffB); PG8_STAGE(PG8_SB(0, 1), cB + hstep, voffB); PG8_STAGE(PG8_SA(0, 0), cA, voffA); PG8_STAGE(PG8_SA(0, 1), cA + hstep, voffA);
        if (wr == 1) PG8_BAR;
        PG8_WAIT_V(2); PG8_BAR;
        PG8_STAGE(PG8_SB(1, 0), cB + kstep, voffB); PG8_STAGE(PG8_SA(1, 0), cA + kstep, voffA); PG8_STAGE(PG8_SB(1, 1), cB + hstep + kstep, voffB);
        PG8_WAIT_V(6); PG8_BAR;
    } else {
        PG8_STAGE(PG8_SB(0, 0), cB, voffB); PG8_STAGE(PG8_SA(0, 0), cA, voffA); PG8_STAGE(PG8_SB(0, 1), cB + hstep, voffB); PG8_STAGE(PG8_SA(0, 1), cA + hstep, voffA);
        if (wr == 1) PG8_BAR;
        PG8_WAIT_V(4); PG8_BAR;
        PG8_STAGE(PG8_SB(1, 0), cB + kstep, voffB); PG8_STAGE(PG8_SA(1, 0), cA + kstep, voffA); PG8_STAGE(PG8_SB(1, 1), cB + hstep + kstep, voffB);
        PG8_WAIT_V(6); PG8_BAR;
    }
    for (;;) {
        const bool has_next = S.next(ui + 1, nxt);
        const char* nA = has_next ? (const char*)g.A + (size_t)nxt.pm * tstep : cA; const char* nB = has_next ? (const char*)g.Bt + (size_t)nxt.pn * tstep : cB;
        for (int t = 0; t < nt; t += 2) {
            const bool last = (t == nt - 2);
            const char* a1 = cA + (size_t)(t + 1) * kstep;
            const char* a2 = last ? nA : cA + (size_t)(t + 2) * kstep; const char* b2 = last ? nB : cB + (size_t)(t + 2) * kstep;
            const char* a3 = a2 + kstep; const char* b3 = b2 + kstep;
            if (last && has_next) S.a_ready(nxt);
            if constexpr (SP2) {
            PG8_LDB(B0, 0, 0); PG8_LDB(B1, 0, 1); PG8_SCHED; PG8_LDA(At, 0, 0); PG8_STAGE(PG8_SA(1, 1), a1 + hstep, voffA);
            PG8_WAIT_V(8); PG8_WAIT_L(0); PG8_BAR; PG8_MMA(0, 0, At, B0); PG8_MMA(0, 1, At, B1); PG8_BAR; PG8_SCHED;
            PG8_LDA(At, 0, 1); PG8_STAGE(PG8_SB(0, 0), b2, voffB); PG8_STAGE(PG8_SB(0, 1), b2 + hstep, voffB); PG8_STAGE(PG8_SA(0, 0), a2, voffA);
            PG8_WAIT_V(8); PG8_WAIT_L(0); PG8_BAR; PG8_MMA(1, 0, At, B0); PG8_MMA(1, 1, At, B1); PG8_BAR; PG8_SCHED;
            PG8_LDB(B0, 1, 0); PG8_LDB(B1, 1, 1); PG8_SCHED; PG8_LDA(At, 1, 0); PG8_STAGE(PG8_SA(0, 1), a2 + hstep, voffA);
            PG8_WAIT_V(8); PG8_WAIT_L(0); PG8_BAR; PG8_MMA(0, 0, At, B0); PG8_MMA(0, 1, At, B1); PG8_BAR; PG8_SCHED;
            PG8_LDA(At, 1, 1); PG8_STAGE(PG8_SB(1, 0), b3, voffB); PG8_STAGE(PG8_SB(1, 1), b3 + hstep, voffB); PG8_STAGE(PG8_SA(1, 0), a3, voffA);
            PG8_WAIT_V(8); PG8_WAIT_L(0); PG8_BAR; PG8_MMA(1, 0, At, B0); PG8_MMA(1, 1, At, B1); PG8_BAR; PG8_SCHED;
            } else {
            PG8_LDB(B0, 0, 0); PG8_SCHED; PG8_LDA(At, 0, 0); PG8_STAGE(PG8_SA(1, 1), a1 + hstep, voffA);
            PG8_WAIT_L(8); PG8_BAR; PG8_WAIT_L(0); PG8_MMA(0, 0, At, B0); PG8_BAR; PG8_SCHED;
            PG8_LDB(B1, 0, 1); PG8_STAGE(PG8_SB(0, 0), b2, voffB);
            PG8_BAR; PG8_WAIT_L(0); PG8_MMA(0, 1, At, B1); PG8_BAR;
            PG8_LDA(At, 0, 1); PG8_STAGE(PG8_SA(0, 0), a2, voffA);
            PG8_BAR; PG8_WAIT_L(0); PG8_MMA(1, 0, At, B0); PG8_BAR; PG8_SCHED;
            PG8_STAGE(PG8_SB(0, 1), b2 + hstep, voffB);
            PG8_WAIT_V(6); PG8_BAR; PG8_MMA(1, 1, At, B1); PG8_BAR;
            PG8_LDB(B0, 1, 0); PG8_SCHED; PG8_LDA(At, 1, 0); PG8_STAGE(PG8_SA(0, 1), a2 + hstep, voffA);
            PG8_WAIT_L(8); PG8_BAR; PG8_WAIT_L(0); PG8_MMA(0, 0, At, B0); PG8_BAR; PG8_SCHED;
            PG8_LDB(B1, 1, 1); PG8_STAGE(PG8_SB(1, 0), b3, voffB);
            PG8_BAR; PG8_WAIT_L(0); PG8_MMA(0, 1, At, B1); PG8_BAR;
            PG8_LDA(At, 1, 1); PG8_STAGE(PG8_SA(1, 0), a3, voffA);
            PG8_BAR; PG8_WAIT_L(0); PG8_MMA(1, 0, At, B0); PG8_BAR; PG8_SCHED;
            PG8_STAGE(PG8_SB(1, 1), b3 + hstep, voffB);
            PG8_WAIT_V(6); PG8_BAR; PG8_MMA(1, 1, At, B1); PG8_BAR;
            }
        }
        if constexpr (ALIGN_EPI) { if (wr == 0) PG8_BAR; }
        if constexpr (!Epi::AFTER_DRAIN) { E(acc, cur, wr, wc, fr, fq); S.done(cur); }
        if (!has_next) break;
#pragma unroll
        for (int a = 0; a < 2; ++a)
#pragma unroll
            for (int b = 0; b < 2; ++b)
#pragma unroll
                for (int m = 0; m < 4; ++m)
#pragma unroll
                    for (int n = 0; n < 2; ++n) acc[a][b][m][n] = (f32x4){0.f, 0.f, 0.f, 0.f};
        cur = nxt; cA = nA; cB = nB; ++ui;
        if constexpr (ALIGN_EPI) { if (wr == 1) PG8_BAR; }
    }
    PG8_WAIT_V(0);
    if constexpr (!ALIGN_EPI) { if (wr == 0) PG8_BAR; }
    PG8_BAR;
    if constexpr (Epi::AFTER_DRAIN) { E.fused(acc, cur, wr, wc, fr, fq, lds, wid, lane); S.done(cur); }
#undef PG8_SA
#undef PG8_SB
#undef PG8_STAGE
#undef PG8_LDA
#undef PG8_LDB
#undef PG8_MMA
#undef PG8_WAIT_V
#undef PG8_WAIT_L
#undef PG8_BAR
#undef PG8_SCHED
}
}

constexpr int DM = 1024, BATCH = 8, SEQ = 4096, DEPTH = 4, MT = BATCH * SEQ;
constexpr int INW = 2304, FFW = 4096, PLEW = 256, SSW = 256;
constexpr int ZK = 512, ZV = 1024, ZC = 1536, ZS = 2048;
constexpr float EPS = 1e-6f;
constexpr int NWAVES = 8, NTHREADS = 512;
constexpr int LDS_BYTES = 147456;
constexpr size_t MiB = 1u << 20;
constexpr size_t WS_SSQA = 1 * MiB, WS_SSQB = 3 * MiB, WS_SSQC = 5 * MiB;
constexpr size_t WS_W = 8 * MiB;
constexpr size_t LW_IN = 0, LW_GLU = LW_IN + (size_t)INW * DM, LW_OUT = LW_GLU + (size_t)SSW * SSW, LW_FF1 = LW_OUT + (size_t)DM * DM,
                 LW_FF2 = LW_FF1 + (size_t)FFW * DM, LW_GATE = LW_FF2 + (size_t)DM * FFW, LW_PLE = LW_GATE + (size_t)DM * DM, LW_ELEMS = LW_PLE + (size_t)DM * PLEW;
constexpr size_t WS_XN = 109 * MiB, WS_PP = 173 * MiB, WS_PBF = 237 * MiB, WS_R = 253 * MiB;
constexpr size_t WS_Z = WS_R, WS_MIX = WS_R + 144 * MiB, WS_YG = WS_MIX + 64 * MiB, WS_STASH = WS_YG + 16 * MiB, WS_HID = WS_R, WS_END = WS_R + 256 * MiB, WS_XN2 = WS_MIX;
static_assert(WS_W + LW_ELEMS * 2 * DEPTH <= WS_XN, "weights fit");
static_assert(WS_STASH + 32 * MiB <= WS_END, "region R");

typedef unsigned short bf16_t;
typedef short bf16x8 __attribute__((ext_vector_type(8)));
typedef short s16x4 __attribute__((ext_vector_type(4)));
typedef float f32x4 __attribute__((ext_vector_type(4)));
typedef float f32x16 __attribute__((ext_vector_type(16)));
typedef unsigned u32x4 __attribute__((ext_vector_type(4)));
typedef unsigned u32x2 __attribute__((ext_vector_type(2)));
#define LAS __attribute__((address_space(3)))

typedef float f32x2_cv2 __attribute__((ext_vector_type(2))); typedef __bf16 bf16x2_cv2 __attribute__((ext_vector_type(2)));
__device__ __forceinline__ unsigned cvtpk(float lo, float hi) { const f32x2_cv2 v = {lo, hi}; const bf16x2_cv2 b = __builtin_convertvector(v, bf16x2_cv2); return __builtin_bit_cast(unsigned, b); }
__device__ __forceinline__ float bflo(unsigned w) { return __uint_as_float(w << 16); }
__device__ __forceinline__ float bfhi(unsigned w) { return __uint_as_float(w & 0xffff0000u); }
__device__ __forceinline__ float sigm(float x) { return __builtin_amdgcn_rcpf(1.0f + __expf(-x)); }
__device__ __forceinline__ float wave_sum(float v) {
#pragma unroll
    for (int o = 1; o < 64; o <<= 1) v += __shfl_xor(v, o);
    return v;
}

struct Args { const float* in[32]; float* out; unsigned char* ws; int ph_lo, ph_hi; };
struct KA { const __attribute__((address_space(4))) Args* p; __device__ __forceinline__ const __attribute__((address_space(4))) Args* operator->() const { return p; } };

__device__ __forceinline__ void transpose_item(const float* W, const float* gain, int K, int N, bf16_t* WT, float* scr, int item, int lane, bool perm = false) {
    const int nblk = N / 64, kb = item / nblk, nb = item % nblk, k0 = 64 * kb, n0 = 64 * nb;
    const int kk = lane >> 4, n4 = (lane & 15) * 4;
#pragma unroll 4
    for (int i = 0; i < 16; ++i) { const int k = 4 * i + kk; f32x4 v = *(const f32x4*)(W + (size_t)(k0 + k) * N + n0 + n4); if (gain) v = v * gain[k0 + k]; *(f32x4*)(scr + k * 68 + n4) = v; }
    asm volatile("s_waitcnt lgkmcnt(0)" ::: "memory");
    const int c = lane & 7;
#pragma unroll
    for (int j = 0; j < 8; ++j) { const int n = (lane >> 3) + 8 * j; const float* s = scr + (8 * c) * 68 + n; const int nl = n0 + n;
        const int nr = perm ? (nl & ~255) + 32 * (4 * ((nl >> 5) & 1) + (((nl >> 5) & 7) >> 1)) + (nl & 31) : nl;
        u32x4 o; o.x = cvtpk(s[0 * 68], s[1 * 68]); o.y = cvtpk(s[2 * 68], s[3 * 68]); o.z = cvtpk(s[4 * 68], s[5 * 68]); o.w = cvtpk(s[6 * 68], s[7 * 68]);
        *(u32x4*)(WT + (size_t)nr * K + k0 + 8 * c) = o; }
    asm volatile("s_waitcnt lgkmcnt(0)" ::: "memory");
}

__device__ __forceinline__ void prologue_phase(const KA a, unsigned char* lds, int bx, int G) {
    int tid_l = threadIdx.x; asm volatile("" : "+v"(tid_l));
    const int tid = tid_l, lane = tid & 63, wave = tid >> 6;
    float* scr = (float*)(lds + wave * 17408);
    const int gw = bx * NWAVES + wave, NGW = G * NWAVES;
    constexpr int I_IN = (DM / 64) * (INW / 64), I_GLU = (SSW / 64) * (SSW / 64), I_OUT = (DM / 64) * (DM / 64), I_FF1 = (DM / 64) * (FFW / 64),
                  I_FF2 = (FFW / 64) * (DM / 64), I_GATE = I_OUT, I_PLE = (PLEW / 64) * (DM / 64), I_LAYER = I_IN + I_GLU + I_OUT + I_FF1 + I_FF2 + I_GATE + I_PLE;
    for (int it = gw; it < I_LAYER * DEPTH; it += NGW) {
        const int L = it / I_LAYER; int r = it % I_LAYER;
        bf16_t* wl = (bf16_t*)(a->ws + WS_W) + (size_t)L * LW_ELEMS;
        if (r < I_IN) { transpose_item(a->in[3] + (size_t)L * DM * INW, a->in[2] + L * DM, DM, INW, wl + LW_IN, scr, r, lane, true); continue; } r -= I_IN;
        if (r < I_GLU) { transpose_item(a->in[23] + (size_t)L * SSW * SSW, nullptr, SSW, SSW, wl + LW_GLU, scr, r, lane); continue; } r -= I_GLU;
        if (r < I_OUT) { transpose_item(a->in[25] + (size_t)L * DM * DM, nullptr, DM, DM, wl + LW_OUT, scr, r, lane); continue; } r -= I_OUT;
        if (r < I_FF1) { transpose_item(a->in[27] + (size_t)L * DM * FFW, a->in[26] + L * DM, DM, FFW, wl + LW_FF1, scr, r, lane); continue; } r -= I_FF1;
        if (r < I_FF2) { transpose_item(a->in[28] + (size_t)L * FFW * DM, nullptr, FFW, DM, wl + LW_FF2, scr, r, lane); continue; } r -= I_FF2;
        if (r < I_GATE) { transpose_item(a->in[30] + (size_t)L * DM * DM, a->in[29] + L * DM, DM, DM, wl + LW_GATE, scr, r, lane); continue; } r -= I_GATE;
        transpose_item(a->in[31] + (size_t)L * PLEW * DM, nullptr, PLEW, DM, wl + LW_PLE, scr, r, lane);
    }
    const float* x = a->in[0]; bf16_t* xn = (bf16_t*)(a->ws + WS_XN); float* ssq = (float*)(a->ws + WS_SSQA);
    for (int m = gw; m < MT; m += NGW) {
        const f32x4* xr = (const f32x4*)(x + (size_t)m * DM) + lane; u32x2* o8 = (u32x2*)(xn + (size_t)m * DM) + lane;
        float s = 0.f;
#pragma unroll
        for (int j = 0; j < 4; ++j) { const f32x4 v = xr[64 * j]; s += (v[0] * v[0] + v[1] * v[1]) + (v[2] * v[2] + v[3] * v[3]);
            u32x2 w; w.x = cvtpk(v[0], v[1]); w.y = cvtpk(v[2], v[3]); o8[64 * j] = w; }
        s = wave_sum(s);
        if (lane < 16) ssq[(size_t)m * 16 + lane] = lane == 0 ? s : 0.f;
    }
}

__device__ __forceinline__ void pcvt_rows(const KA a, int L, int row_lo, int nrows) {
    int tid_l = threadIdx.x; asm volatile("" : "+v"(tid_l));
    const int tid = tid_l, lane = tid & 63, wave = tid >> 6;
    bf16_t* pbf = (bf16_t*)(a->ws + WS_PBF); const float* p = a->in[1] + (size_t)L * MT * PLEW;
    for (int i = wave * 4; i < nrows; i += NWAVES * 4) { f32x4 pv[4];
#pragma unroll
        for (int j = 0; j < 4; ++j) pv[j] = *((const f32x4*)(p + (size_t)(row_lo + i + j) * PLEW) + lane);
#pragma unroll
        for (int j = 0; j < 4; ++j) { u32x2 w; w.x = cvtpk(pv[j][0], pv[j][1]); w.y = cvtpk(pv[j][2], pv[j][3]); *((u32x2*)(pbf + (size_t)(row_lo + i + j) * PLEW) + lane) = w; } }
}

__device__ __forceinline__ void conv_unit(const KA a, int L, int unit, unsigned char* lds) {
    int tid_l = threadIdx.x; asm volatile("" : "+v"(tid_l));
    const int tid = tid_l, lane = tid & 63, wave = tid >> 6;
    const int b = unit >> 7, t0 = (unit & 127) * 32; const size_t rb = (size_t)b * SEQ;
    const bf16_t* z = (const bf16_t*)(a->ws + WS_Z); bf16_t* mix = (bf16_t*)(a->ws + WS_MIX);
    float* hcv = (float*)lds; float* cv = (float*)(lds + 62 * 256 * 4);
    u32x4 aw[4], gw[4];
#pragma unroll
    for (int i = 0; i < 4; ++i) { const int it = tid + NTHREADS * i; const int r = it >> 5, ch = (it & 31) * 8; const int t = t0 - 30 + r;
        if (it < 62 * 32 && t >= 0) { const bf16_t* zr = z + (rb + t) * INW + ZC + ch; aw[i] = *(const u32x4*)zr; gw[i] = *(const u32x4*)(zr + 256); }
        else { aw[i] = (u32x4){0u, 0u, 0u, 0u}; gw[i] = (u32x4){0u, 0u, 0u, 0u}; } }
    const int c = tid & 255, half = tid >> 8; const float* cw = a->in[11] + (size_t)L * 31 * 256 + c; const float cb = a->in[12][L * 256 + c];
    float w[31];
#pragma unroll
    for (int k = 0; k < 31; ++k) w[k] = cw[k * 256];
#pragma unroll
    for (int i = 0; i < 4; ++i) { const int it = tid + NTHREADS * i; const int r = it >> 5, ch = (it & 31) * 8;
        if (it < 62 * 32) { float v[8];
            v[0] = bflo(aw[i].x) * sigm(bflo(gw[i].x)); v[1] = bfhi(aw[i].x) * sigm(bfhi(gw[i].x)); v[2] = bflo(aw[i].y) * sigm(bflo(gw[i].y)); v[3] = bfhi(aw[i].y) * sigm(bfhi(gw[i].y));
            v[4] = bflo(aw[i].z) * sigm(bflo(gw[i].z)); v[5] = bfhi(aw[i].z) * sigm(bfhi(gw[i].z)); v[6] = bflo(aw[i].w) * sigm(bflo(gw[i].w)); v[7] = bfhi(aw[i].w) * sigm(bfhi(gw[i].w));
            *(f32x4*)(hcv + r * 256 + ch) = (f32x4){v[0], v[1], v[2], v[3]}; *(f32x4*)(hcv + r * 256 + ch + 4) = (f32x4){v[4], v[5], v[6], v[7]}; } }
    __syncthreads();
    { float win[46];
#pragma unroll
        for (int j = 0; j < 46; ++j) win[j] = hcv[(half * 16 + j) * 256 + c];
#pragma unroll
        for (int tt = 0; tt < 16; ++tt) { float acc = cb;
#pragma unroll
            for (int k = 0; k < 31; ++k) acc += w[k] * win[tt + k];
            cv[(half * 16 + tt) * 256 + c] = acc; } }
    __syncthreads();
    { const f32x4 g = *((const f32x4*)(a->in[13] + L * 256) + lane), bb = *((const f32x4*)(a->in[14] + L * 256) + lane);
#pragma unroll
        for (int i = 0; i < 4; ++i) { const int t = wave * 4 + i; const f32x4 xv = *((const f32x4*)(cv + t * 256) + lane);
            const float mu = wave_sum((xv[0] + xv[1]) + (xv[2] + xv[3])) * (1.0f / 256.0f);
            const f32x4 d = xv - mu; const float var = wave_sum((d[0] * d[0] + d[1] * d[1]) + (d[2] * d[2] + d[3] * d[3])) * (1.0f / 256.0f);
            const float rs = rsqrtf(var + EPS); f32x4 y = d * rs * g + bb;
#pragma unroll
            for (int e = 0; e < 4; ++e) y[e] = y[e] * sigm(y[e]);
            u32x2 w2; w2.x = cvtpk(y[0], y[1]); w2.y = cvtpk(y[2], y[3]); *((u32x2*)(mix + (rb + t0 + t) * DM + 512) + lane) = w2; } }
    __syncthreads();
}

__device__ __forceinline__ float gelu_tanh(float y) { const float z = 0.7978845608028654f * (y + 0.044715f * y * y * y); const float t = 1.0f - 2.0f / (1.0f + __expf(2.0f * z)); return 0.5f * y * (1.0f + t); }

__device__ __forceinline__ void ssm_bfrag(const KA a, int lg, float dt, int nb, int lane, bf16x8& bhi, bf16x8& blo) {
    const int p = (lane & 31) + 32 * (nb & 1), c0 = 8 * (lane >> 5);
    const float lr = a->in[15][lg * 64 + p], li = a->in[16][lg * 64 + p]; const float ea = expf(lr * dt), th = li * dt; const float par = ea * cosf(th), pai = ea * sinf(th);
    const float den = 1.0f / (lr * lr + li * li); const float nr = par - 1.0f; const float cr = (nr * lr + pai * li) * den, ci = (pai * lr - nr * li) * den;
    const float* bre = a->in[18] + ((size_t)lg * 64 + p) * 16 + c0; const float* bim = a->in[19] + ((size_t)lg * 64 + p) * 16 + c0;
    float v[8];
    { const f32x4 xr0 = *(const f32x4*)bre, xr1 = *(const f32x4*)(bre + 4), xi0 = *(const f32x4*)bim, xi1 = *(const f32x4*)(bim + 4);
      const float xs[8] = {xr0[0], xr0[1], xr0[2], xr0[3], xr1[0], xr1[1], xr1[2], xr1[3]}, ys[8] = {xi0[0], xi0[1], xi0[2], xi0[3], xi1[0], xi1[1], xi1[2], xi1[3]};
#pragma unroll
      for (int j = 0; j < 8; ++j) v[j] = (nb >> 1) ? (cr * ys[j] + ci * xs[j]) : (cr * xs[j] - ci * ys[j]); }
    u32x4 wh, wl; float rem[8];
    wh.x = cvtpk(v[0], v[1]); wh.y = cvtpk(v[2], v[3]); wh.z = cvtpk(v[4], v[5]); wh.w = cvtpk(v[6], v[7]);
    rem[0] = v[0] - bflo(wh.x); rem[1] = v[1] - bfhi(wh.x); rem[2] = v[2] - bflo(wh.y); rem[3] = v[3] - bfhi(wh.y);
    rem[4] = v[4] - bflo(wh.z); rem[5] = v[5] - bfhi(wh.z); rem[6] = v[6] - bflo(wh.w); rem[7] = v[7] - bfhi(wh.w);
    wl.x = cvtpk(rem[0], rem[1]); wl.y = cvtpk(rem[2], rem[3]); wl.z = cvtpk(rem[4], rem[5]); wl.w = cvtpk(rem[6], rem[7]);
    bhi = *reinterpret_cast<bf16x8*>(&wh); blo = *reinterpret_cast<bf16x8*>(&wl);
}
__device__ __forceinline__ void ssm_s1_block(const bf16_t* usb, float* bur, float* bui, int blk, int lane, bf16x8 bhi, bf16x8 blo) {
    constexpr int XS = 68; const int mb = blk >> 2, nb = blk & 3;
    const bf16x8 af = *(const bf16x8*)(usb + (mb * 32 + (lane & 31)) * 16 + 8 * (lane >> 5));
    f32x16 acc = f32x16{};
    acc = __builtin_amdgcn_mfma_f32_32x32x16_bf16(af, bhi, acc, 0, 0, 0);
    acc = __builtin_amdgcn_mfma_f32_32x32x16_bf16(af, blo, acc, 0, 0, 0);
    float* dst = ((nb >> 1) ? bui : bur) + (lane & 31) + 32 * (nb & 1); const int hi = lane >> 5;
#pragma unroll
    for (int r = 0; r < 16; ++r) dst[(mb * 32 + (r & 3) + 8 * (r >> 2) + 4 * hi) * XS] = acc[r];
}
__device__ __forceinline__ void ssm_unit(const KA a, int L, int unit, unsigned char* lds) {
    int tid_l = threadIdx.x; asm volatile("" : "+v"(tid_l));
    const int tid = tid_l, lane = tid & 63, wave = __builtin_amdgcn_readfirstlane(tid >> 6);
    const int b = unit >> 4, g = unit & 15, lg = L * 16 + g; const size_t rb = (size_t)b * SEQ;
    const bf16_t* z = (const bf16_t*)(a->ws + WS_Z); bf16_t* yg = (bf16_t*)(a->ws + WS_YG);
    constexpr int XS = 68, XF = 132, NCH = SEQ / 64;
    constexpr int OFF_BU = 8192, BU_BYTES = 2 * 64 * XS * 4, OFF_X = OFF_BU + 2 * BU_BYTES, X_BYTES = 64 * XF * 4;
    static_assert(OFF_X + 2 * X_BYTES <= LDS_BYTES - 64, "ssm LDS map");
    const float dt = expf(a->in[17][lg]);
    float ar, ai;
    { const float lr = a->in[15][lg * 64 + lane], li = a->in[16][lg * 64 + lane]; const float ea = expf(lr * dt), th = li * dt; ar = ea * cosf(th); ai = ea * sinf(th); }
    bf16x8 bhi, blo, bhi0, blo0;
    ssm_bfrag(a, lg, dt, wave & 3, lane, bhi, blo); ssm_bfrag(a, lg, dt, 0, lane, bhi0, blo0);
    bf16x8 w3[4];
    { const int c = lane & 15, kg = lane >> 4;
      f32x4 cf[4][2];
#pragma unroll
      for (int s4 = 0; s4 < 4; ++s4) { const float* src = (s4 < 2 ? a->in[20] : a->in[21]) + ((size_t)lg * 16 + c) * 64 + 32 * (s4 & 1) + 8 * kg; cf[s4][0] = *(const f32x4*)src; cf[s4][1] = *(const f32x4*)(src + 4); }
#pragma unroll
      for (int s4 = 0; s4 < 4; ++s4) { const float sg = s4 < 2 ? 1.f : -1.f; const f32x4 c0 = cf[s4][0] * sg, c1 = cf[s4][1] * sg;
          u32x4 w; w.x = cvtpk(c0[0], c0[1]); w.y = cvtpk(c0[2], c0[3]); w.z = cvtpk(c1[0], c1[1]); w.w = cvtpk(c1[2], c1[3]);
          w3[s4] = *reinterpret_cast<bf16x8*>(&w); } }
    const float dco = a->in[22][lg * 16 + (lane & 15)];
    float sr = 0.f, si = 0.f;
    const bool loader = (wave == 2 || wave == 3); const int lidx = tid - 128, lt = lidx >> 1, lhf = lidx & 1;
    const bf16_t* usrc = z + (rb + (loader ? lt : 0)) * INW + ZS + g * 16 + (loader ? lhf : 0) * 8;
    u32x4 ureg = (u32x4){0u, 0u, 0u, 0u};
    if (loader) ureg = *(const u32x4*)usrc;
    for (int it = -2; it <= NCH; ++it) {
        if (loader) { const int ck = it + 2;
            if (ck < NCH) *(u32x4*)((bf16_t*)(lds + (ck & 3) * 2048) + lt * 16 + lhf * 8) = ureg;
            if (ck + 1 < NCH) ureg = *(const u32x4*)(usrc + (size_t)(ck + 1) * 64 * INW); }
        { const int ck = it + 1;
          if (ck >= 0 && ck < NCH && wave >= 1) { const bf16_t* usb = (const bf16_t*)(lds + (ck & 3) * 2048); float* bur = (float*)(lds + OFF_BU + (ck & 1) * BU_BYTES); float* bui = bur + 64 * XS;
              ssm_s1_block(usb, bur, bui, wave, lane, bhi, blo);
              if (wave == 1) ssm_s1_block(usb, bur, bui, 0, lane, bhi0, blo0); } }
        if (wave == 0 && it >= 0 && it < NCH) {
            const float* bur = (const float*)(lds + OFF_BU + (it & 1) * BU_BYTES); const float* bui = bur + 64 * XS; float* X = (float*)(lds + OFF_X + (it & 1) * X_BYTES);
            const int p = lane; float rr[8], ii[8];
#pragma unroll
            for (int j = 0; j < 8; ++j) { rr[j] = bur[j * XS + p]; ii[j] = bui[j * XS + p]; }
#pragma unroll
            for (int blk = 0; blk < 8; ++blk) { float nr_[8], ni_[8];
                if (blk < 7) {
#pragma unroll
                    for (int j = 0; j < 8; ++j) { nr_[j] = bur[((blk + 1) * 8 + j) * XS + p]; ni_[j] = bui[((blk + 1) * 8 + j) * XS + p]; } }
#pragma unroll
                for (int j = 0; j < 8; ++j) { const float n_r = ar * sr - ai * si + rr[j], n_i = ar * si + ai * sr + ii[j]; sr = n_r; si = n_i;
                    X[(blk * 8 + j) * XF + p] = sr; X[(blk * 8 + j) * XF + 64 + p] = si; }
                if (blk < 7) {
#pragma unroll
                    for (int j = 0; j < 8; ++j) { rr[j] = nr_[j]; ii[j] = ni_[j]; } } } }
        { const int ck = it - 1;
          if (ck >= 0 && wave >= 4) { const int tb = wave - 4, c = lane & 15, kg = lane >> 4; const int t0 = ck * 64;
              const float* X = (const float*)(lds + OFF_X + (ck & 1) * X_BYTES); const bf16_t* usb = (const bf16_t*)(lds + (ck & 3) * 2048);
              f32x4 acc = (f32x4){0.f, 0.f, 0.f, 0.f};
#pragma unroll
              for (int s4 = 0; s4 < 4; ++s4) { const f32x4* xp = (const f32x4*)(X + (tb * 16 + (lane & 15)) * XF + 32 * s4 + 8 * kg); const f32x4 x0 = xp[0], x1 = xp[1];
                  u32x4 w; w.x = cvtpk(x0[0], x0[1]); w.y = cvtpk(x0[2], x0[3]); w.z = cvtpk(x1[0], x1[1]); w.w = cvtpk(x1[2], x1[3]);
                  acc = __builtin_amdgcn_mfma_f32_16x16x32_bf16(*reinterpret_cast<bf16x8*>(&w), w3[s4], acc, 0, 0, 0); }
#pragma unroll
              for (int r = 0; r < 4; ++r) { const int t = tb * 16 + 4 * kg + r; const float u = __uint_as_float((unsigned)usb[t * 16 + c] << 16);
                  const float y = acc[r] + dco * u; const unsigned w = cvtpk(gelu_tanh(y), 0.f);
                  __hip_atomic_store(yg + (rb + t0 + t) * SSW + g * 16 + c, (bf16_t)(w & 0xffffu), __ATOMIC_RELAXED, __HIP_MEMORY_SCOPE_AGENT); } } }
        __syncthreads();
    }
}

namespace att {
constexpr float SCALE = 0.125f, THR = 8.f;
constexpr int SHM_V = 64 * 128 * 2, SHM_K = 64 * 64 * 2;
constexpr int OFF_V = 0, OFF_K = 2 * SHM_V, OFF_WS = OFF_K + 2 * SHM_K;
#define KSWZ(row, colB) ((row) * 128 + ((colB) ^ ((((row) >> 1) & 7) << 4)))
#define SBAR() __builtin_amdgcn_sched_barrier(0)
__device__ __forceinline__ int crow(int r, int hi) { return (r & 3) + 8 * (r >> 2) + 4 * hi; }

__device__ __forceinline__ void partialSM(f32x16& p0, f32x16& p1, float& m_reg, float& alpha) {
    constexpr float C = SCALE * 1.4426950408889634f;
    float pmax = p0[0];
#pragma unroll
    for (int r = 1; r < 16; ++r) pmax = fmaxf(pmax, p0[r]);
#pragma unroll
    for (int r = 0; r < 16; ++r) pmax = fmaxf(pmax, p1[r]);
    { auto rr = __builtin_amdgcn_permlane32_swap(__float_as_uint(pmax), __float_as_uint(pmax), false, false);
      pmax = fmaxf(__uint_as_float(rr[0]), __uint_as_float(rr[1])); }
    float mn;
    if (__builtin_expect(__all(pmax - m_reg <= THR / SCALE), 1)) { mn = m_reg; alpha = 1.f; }
    else { mn = fmaxf(m_reg, pmax); alpha = __builtin_amdgcn_exp2f((m_reg - mn) * C); m_reg = mn; }
    const float mnC = -mn * C;
#pragma unroll
    for (int r = 0; r < 16; ++r) p0[r] = __builtin_amdgcn_exp2f(fmaf(p0[r], C, mnC));
#pragma unroll
    for (int r = 0; r < 16; ++r) p1[r] = __builtin_amdgcn_exp2f(fmaf(p1[r], C, mnC));
}
__device__ __forceinline__ void finishSM(f32x16& p0, f32x16& p1, float alpha, float& l_reg, bf16x8& pa0, bf16x8& pa1, bf16x8& pa2, bf16x8& pa3) {
    float ps = 0;
#pragma unroll
    for (int r = 0; r < 16; ++r) ps += p0[r];
#pragma unroll
    for (int r = 0; r < 16; ++r) ps += p1[r];
    { auto rr = __builtin_amdgcn_permlane32_swap(__float_as_uint(ps), __float_as_uint(ps), false, false);
      ps = __uint_as_float(rr[0]) + __uint_as_float(rr[1]); }
    l_reg = l_reg * alpha + ps;
#define PK4(P, BASE, OUT) do { unsigned a0 = cvtpk(P[BASE + 0], P[BASE + 1]), a1 = cvtpk(P[BASE + 2], P[BASE + 3]);   \
    unsigned b0 = cvtpk(P[BASE + 4], P[BASE + 5]), b1 = cvtpk(P[BASE + 6], P[BASE + 7]);                              \
    auto r0 = __builtin_amdgcn_permlane32_swap(a0, b0, false, false); auto r1 = __builtin_amdgcn_permlane32_swap(a1, b1, false, false); \
    u32x4 w = {r0[0], r1[0], r0[1], r1[1]}; OUT = *reinterpret_cast<bf16x8*>(&w); } while (0)
    PK4(p0, 0, pa0); PK4(p0, 8, pa1); PK4(p1, 0, pa2); PK4(p1, 8, pa3);
#undef PK4
}
__device__ __forceinline__ int v_st(int k, int c) { const int kk = (k & ~0xC) | ((k & 4) << 1) | ((k & 8) >> 1); return ((kk >> 3) * 4 + (c >> 5)) * 512 + ((kk & 7) * 32 + (c & 31)) * 2; }
__device__ __forceinline__ int v_rd_base(int lane) { return ((lane & 3) << 3) | (((lane >> 2) & 3) << 6) | (((lane >> 4) & 1) << 5) | (((lane >> 5) & 1) << 8); }
constexpr int v_rd_off(int d0, int ks, int half) { return d0 * 512 + ks * 4096 + half * 2048; }
template <int OFF> __device__ __forceinline__ s16x4 tr_read(int vb) {
    s16x4 r; asm volatile("ds_read_b64_tr_b16 %0, %1 offset:%2" : "=&v"(r) : "v"(vb), "i"(OFF) : "memory"); return r;
}
template <int D0> __device__ __forceinline__ void pv_one(f32x16& od, int vb, bf16x8 pa0, bf16x8 pa1, bf16x8 pa2, bf16x8 pa3) {
    const s16x4 l0 = tr_read<v_rd_off(D0, 0, 0)>(vb), h0 = tr_read<v_rd_off(D0, 0, 1)>(vb), l1 = tr_read<v_rd_off(D0, 1, 0)>(vb), h1 = tr_read<v_rd_off(D0, 1, 1)>(vb);
    const s16x4 l2 = tr_read<v_rd_off(D0, 2, 0)>(vb), h2 = tr_read<v_rd_off(D0, 2, 1)>(vb), l3 = tr_read<v_rd_off(D0, 3, 0)>(vb), h3 = tr_read<v_rd_off(D0, 3, 1)>(vb);
    asm volatile("s_waitcnt lgkmcnt(0)" ::: "memory"); SBAR();
#define PK(Lo, Hi) (bf16x8){Lo[0], Lo[1], Lo[2], Lo[3], Hi[0], Hi[1], Hi[2], Hi[3]}
    od = __builtin_amdgcn_mfma_f32_32x32x16_bf16(pa0, PK(l0, h0), od, 0, 0, 0);
    od = __builtin_amdgcn_mfma_f32_32x32x16_bf16(pa1, PK(l1, h1), od, 0, 0, 0);
    od = __builtin_amdgcn_mfma_f32_32x32x16_bf16(pa2, PK(l2, h2), od, 0, 0, 0);
    od = __builtin_amdgcn_mfma_f32_32x32x16_bf16(pa3, PK(l3, h3), od, 0, 0, 0);
#undef PK
}

template <int D0> __device__ __forceinline__ void pv_rd(s16x4 (&f)[8], int vb) {
    f[0] = tr_read<v_rd_off(D0, 0, 0)>(vb); f[1] = tr_read<v_rd_off(D0, 0, 1)>(vb); f[2] = tr_read<v_rd_off(D0, 1, 0)>(vb); f[3] = tr_read<v_rd_off(D0, 1, 1)>(vb);
    f[4] = tr_read<v_rd_off(D0, 2, 0)>(vb); f[5] = tr_read<v_rd_off(D0, 2, 1)>(vb); f[6] = tr_read<v_rd_off(D0, 3, 0)>(vb); f[7] = tr_read<v_rd_off(D0, 3, 1)>(vb);
}
__device__ __forceinline__ void pv_mm(f32x16& od, const s16x4 (&f)[8], bf16x8 pa0, bf16x8 pa1, bf16x8 pa2, bf16x8 pa3) {
#define PK(Lo, Hi) (bf16x8){Lo[0], Lo[1], Lo[2], Lo[3], Hi[0], Hi[1], Hi[2], Hi[3]}
    od = __builtin_amdgcn_mfma_f32_32x32x16_bf16(pa0, PK(f[0], f[1]), od, 0, 0, 0);
    od = __builtin_amdgcn_mfma_f32_32x32x16_bf16(pa1, PK(f[2], f[3]), od, 0, 0, 0);
    od = __builtin_amdgcn_mfma_f32_32x32x16_bf16(pa2, PK(f[4], f[5]), od, 0, 0, 0);
    od = __builtin_amdgcn_mfma_f32_32x32x16_bf16(pa3, PK(f[6], f[7]), od, 0, 0, 0);
#undef PK
}
__device__ __forceinline__ void pv_all(f32x16 (&o)[4], int vb, bf16x8 pa0, bf16x8 pa1, bf16x8 pa2, bf16x8 pa3) {
    s16x4 fa[8], fb[8];
    pv_rd<0>(fa, vb); pv_rd<1>(fb, vb);
    asm volatile("s_waitcnt lgkmcnt(8)" ::: "memory"); SBAR(); pv_mm(o[0], fa, pa0, pa1, pa2, pa3); SBAR();
    pv_rd<2>(fa, vb);
    asm volatile("s_waitcnt lgkmcnt(8)" ::: "memory"); SBAR(); pv_mm(o[1], fb, pa0, pa1, pa2, pa3); SBAR();
    pv_rd<3>(fb, vb);
    asm volatile("s_waitcnt lgkmcnt(8)" ::: "memory"); SBAR(); pv_mm(o[2], fa, pa0, pa1, pa2, pa3); SBAR();
    asm volatile("s_waitcnt lgkmcnt(0)" ::: "memory"); SBAR(); pv_mm(o[3], fb, pa0, pa1, pa2, pa3);
}
constexpr int OFFK_K = 0, OFFK_V = 4 * SHM_K, OFFK_WS = OFFK_V + 4 * SHM_V, OFFK_DN = OFFK_WS + 8 * 256;
__device__ __forceinline__ void attn_unit_k(const KA a, int L, int b, int h, int qbp, char* lds, float* stash, float lam, float lam_init, float smax_raw) {
    int tid_l = threadIdx.x; asm volatile("" : "+v"(tid_l));
    const int tid = tid_l, lane = tid & 63, r32 = lane & 31, hi = lane >> 5; const int wid = __builtin_amdgcn_readfirstlane(tid >> 6);
    const int grp = wid >> 2, wq = wid & 3, t256 = tid & 255;
    const bf16_t* z = (const bf16_t*)(a->ws + WS_Z); bf16_t* mix = (bf16_t*)(a->ws + WS_MIX);
    const bool pair = h < 2; const int step = pair ? 1 : 2;
    const int qb128 = pair ? 2 * qbp + grp : qbp;
    const size_t rb = (size_t)b * SEQ; const int q0 = qb128 * 128;
    const int NT = 2 * qb128 + 2, NI = pair ? 4 * qbp + 4 : qbp + 1, jmax = 2 * qb128 + (wq >> 1);
    const float slope = exp2f(-2.0f * (float)(h + 1));
    const float nb = -slope / SCALE;
    constexpr float C = SCALE * 1.4426950408889634f;
    char* K_lds = lds + OFFK_K + grp * SHM_K; char* V_lds = lds + OFFK_V + grp * SHM_V;
    float* wsf = (float*)(lds + OFFK_WS) + wid * 64; float* li_l = wsf; float* al_l = wsf + 32;
    unsigned* dn = (unsigned*)(lds + OFFK_DN);
    const int vb0 = (int)(uintptr_t)V_lds + v_rd_base(lane);
    int kso[2], vso[4];
#pragma unroll
    for (int i = 0; i < 2; ++i) { const int ci = (2 * wq + i) * 64 + lane, row = ci >> 3, sc_ = (ci & 7) ^ ((row >> 1) & 7); kso[i] = row * INW + sc_ * 8; }
#pragma unroll
    for (int i = 0; i < 4; ++i) { const int ci = (4 * wq + i) * 64 + lane, sub = ci >> 5, within = ci & 31; const int kk = (sub >> 2) * 8 + (within >> 2);
        const int k = (kk & ~0xC) | ((kk & 4) << 1) | ((kk & 8) >> 1); const int c_ = (sub & 3) * 32 + (within & 3) * 8; vso[i] = k * INW + c_; }
    const int qpos = q0 + wq * 32 + r32;
    f32x16 o[4];
    for (int c = 0; c < 2; ++c) {
        const bf16_t* Kg = z + rb * INW + ZK + h * 128 + c * 64;
        const bf16_t* Vg = z + rb * INW + ZV + h * 128;
        const bf16_t* Qw = z + (rb + qpos) * INW + h * 128 + c * 64 + hi * 8;
        bf16x8 qr[4];
#pragma unroll
        for (int d0 = 0; d0 < 4; ++d0) qr[d0] = *(const bf16x8*)(Qw + d0 * 16);
        float m_reg = -1e30f, l_reg = 0.f;
#pragma unroll
        for (int d = 0; d < 4; ++d) o[d] = f32x16{};
#define ATT_DMA(TILE, BUF) do { const size_t ro_ = (size_t)(TILE) * 64 * INW; \
            _Pragma("unroll") for (int i_ = 0; i_ < 2; ++i_) __builtin_amdgcn_global_load_lds((const unsigned*)(Kg + ro_ + kso[i_]), (LAS unsigned*)(K_lds + (BUF) * 2 * SHM_K + (2 * wq + i_) * 1024), 16, 0, 0); \
            _Pragma("unroll") for (int i_ = 0; i_ < 4; ++i_) __builtin_amdgcn_global_load_lds((const unsigned*)(Vg + ro_ + vso[i_]), (LAS unsigned*)(V_lds + (BUF) * 2 * SHM_V + (4 * wq + i_) * 1024), 16, 0, 0); } while (0)
        ATT_DMA(pair ? NT - 1 : NT - 2 + grp, 0);
        if (tid < 16) dn[tid] = 0u;
        bool done = false;
        for (int it = 0; it < NI; ++it) { const int J = pair ? NT - 1 - it : NT - 2 - 2 * it + grp, buf = it & 1;
            asm volatile("s_waitcnt vmcnt(0)" ::: "memory");
            if (lane == 0 && done) dn[buf * 8 + wid] = 1u;
            __syncthreads();
#ifndef ATT_NO_SKIP
            { const u32x4 d0v = *(const u32x4*)(dn + buf * 8), d1v = *(const u32x4*)(dn + buf * 8 + 4);
              if ((d0v.x & d0v.y & d0v.z & d0v.w & d1v.x & d1v.y & d1v.z & d1v.w) != 0u) break; }
#endif
            if (it + 1 < NI && J - step >= 0) ATT_DMA(J - step, buf ^ 1);
            if (J >= 0 && J <= jmax && !done) {
                f32x16 p0, p1;
                { const float dq = (float)(qpos - J * 64 - 4 * hi);
                  if (J < jmax) { const float base = nb * dq;
#pragma unroll
                      for (int r = 0; r < 16; ++r) { const float cr_ = (float)((r & 3) + 8 * (r >> 2)); p0[r] = fmaf(-cr_, nb, base); p1[r] = fmaf(-(cr_ + 32.f), nb, base); } }
                  else {
#pragma unroll
                      for (int r = 0; r < 16; ++r) { const float ar_ = dq - (float)((r & 3) + 8 * (r >> 2)); p0[r] = nb * fabsf(ar_); p1[r] = nb * fabsf(ar_ - 32.f); } } }
                const char* Ks = K_lds + buf * 2 * SHM_K;
                bf16x8 kf[8];
#pragma unroll
                for (int d0 = 0; d0 < 4; ++d0) { const int cb = (d0 * 16 + hi * 8) * 2; kf[2 * d0] = *(const bf16x8*)(Ks + KSWZ(r32, cb)); kf[2 * d0 + 1] = *(const bf16x8*)(Ks + KSWZ(32 + r32, cb)); }
#pragma unroll
                for (int d0 = 0; d0 < 4; ++d0) { asm volatile("" : "+v"(kf[2 * d0]), "+v"(kf[2 * d0 + 1]));
                    p0 = __builtin_amdgcn_mfma_f32_32x32x16_bf16(kf[2 * d0], qr[d0], p0, 0, 0, 0);
                    p1 = __builtin_amdgcn_mfma_f32_32x32x16_bf16(kf[2 * d0 + 1], qr[d0], p1, 0, 0, 0); }
                float alpha;
                partialSM(p0, p1, m_reg, alpha);
                if (__any(alpha < 1.f)) { if (hi == 0) al_l[r32] = alpha; asm volatile("s_waitcnt lgkmcnt(0)" ::: "memory");
#pragma unroll
                    for (int d = 0; d < 4; ++d)
#pragma unroll
                        for (int r = 0; r < 16; ++r) o[d][r] *= al_l[crow(r, hi)]; }
                bf16x8 pa0, pa1, pa2, pa3;
                finishSM(p0, p1, alpha, l_reg, pa0, pa1, pa2, pa3); SBAR();
                const int vb = vb0 + buf * 2 * SHM_V;
                pv_all(o, vb, pa0, pa1, pa2, pa3);
            }
#ifndef ATT_NO_SKIP
            if (!done) {
                float mmin = m_reg;
#pragma unroll
                for (int o_ = 1; o_ < 64; o_ <<= 1) mmin = fminf(mmin, __shfl_xor(mmin, o_));
                const float dmin = (float)(q0 + wq * 32 - ((J - step) * 64 + 63));
                done = (J - step < 0) || ((smax_raw + nb * dmin - mmin) * C < -32.0f);
            }
#endif
        }
#undef ATT_DMA
        __syncthreads();
        float* cmb = (float*)lds + wq * 4096;
        float* cml = (float*)(lds + 4 * 16384) + wq * 128;
        if (grp == 1 && !pair) {
#pragma unroll
            for (int d = 0; d < 4; ++d)
#pragma unroll
                for (int r = 0; r < 16; ++r) cmb[(d * 16 + r) * 64 + lane] = o[d][r];
            cml[lane] = m_reg; cml[64 + lane] = l_reg; }
        __syncthreads();
        if (grp == 0 && !pair) {
            const float mB = cml[lane], lB = cml[64 + lane]; const float mN = fmaxf(m_reg, mB);
            const float fA = __builtin_amdgcn_exp2f((m_reg - mN) * C), fB = __builtin_amdgcn_exp2f((mB - mN) * C);
            l_reg = l_reg * fA + lB * fB;
            if (hi == 0) { al_l[r32] = fA; li_l[r32] = fB; } asm volatile("s_waitcnt lgkmcnt(0)" ::: "memory");
            float fa[16], fb[16];
#pragma unroll
            for (int r = 0; r < 16; ++r) { fa[r] = al_l[crow(r, hi)]; fb[r] = li_l[crow(r, hi)]; }
#pragma unroll
            for (int d = 0; d < 4; ++d)
#pragma unroll
                for (int r = 0; r < 16; ++r) o[d][r] = o[d][r] * fa[r] + cmb[(d * 16 + r) * 64 + lane] * fb[r];
            asm volatile("s_waitcnt lgkmcnt(0)" ::: "memory");
        }
        if (grp == 0 || pair) {
            if (hi == 0) li_l[r32] = l_reg; asm volatile("s_waitcnt lgkmcnt(0)" ::: "memory");
            float rli[16];
#pragma unroll
            for (int r = 0; r < 16; ++r) rli[r] = __builtin_amdgcn_rcpf(li_l[crow(r, hi)]);
#pragma unroll
            for (int d = 0; d < 4; ++d)
#pragma unroll
                for (int r = 0; r < 16; ++r) o[d][r] *= rli[r];
            if (c == 0) {
                f32x4* sp = (f32x4*)(stash + tid * 64);
#pragma unroll
                for (int d = 0; d < 4; ++d)
#pragma unroll
                    for (int r4 = 0; r4 < 4; ++r4) sp[d * 4 + r4] = (f32x4){o[d][4 * r4], o[d][4 * r4 + 1], o[d][4 * r4 + 2], o[d][4 * r4 + 3]};
            }
        }
        asm volatile("s_waitcnt lgkmcnt(0)" ::: "memory");
        __syncthreads();
    }
    if (grp == 0 || pair) {
        { const f32x4* sp = (const f32x4*)(stash + tid * 64);
#pragma unroll
        for (int d = 0; d < 4; ++d)
#pragma unroll
            for (int r4 = 0; r4 < 4; ++r4) { const f32x4 sv = sp[d * 4 + r4];
#pragma unroll
                for (int e = 0; e < 4; ++e) o[d][4 * r4 + e] = sv[e] - lam * o[d][4 * r4 + e]; } }
        const float* og = a->in[10] + L * 128; const float osc = 1.0f - lam_init;
        float gn[4];
#pragma unroll
        for (int d = 0; d < 4; ++d) gn[d] = og[d * 32 + r32] * osc;
#pragma unroll
        for (int r = 0; r < 16; ++r) { float s = (o[0][r] * o[0][r] + o[1][r] * o[1][r]) + (o[2][r] * o[2][r] + o[3][r] * o[3][r]);
            s += __shfl_xor(s, 1); s += __shfl_xor(s, 2); s += __shfl_xor(s, 4); s += __shfl_xor(s, 8); s += __shfl_xor(s, 16);
            const float rs = rsqrtf(s * (1.0f / 128.0f) + EPS);
            bf16_t* orow = mix + (rb + q0 + wq * 32 + crow(r, hi)) * DM + h * 128 + r32;
#pragma unroll
            for (int d = 0; d < 4; ++d) { const unsigned w = cvtpk(o[d][r] * rs * gn[d], 0.f); orow[d * 32] = (bf16_t)(w & 0xffffu); } }
    }
}
#undef KSWZ
#undef SBAR
}

#define GAS __attribute__((address_space(1)))
#define XB_TMO      128
#define XB_XCNT(j)  (256  + 64 * (j))
#define XB_XSUB(j)  (1280 + 64 * (j))
#define XB_XGEN(j)  (2304 + 64 * (j))
#define XB_TOP      3328
#define XB_TOPGEN   3392
#define XCD_BAR_WORDS 3456
#define XB_SPIN_CAP (1u << 18)

__device__ __forceinline__ unsigned xb_ld(unsigned* p)              { return __hip_atomic_load(p, __ATOMIC_RELAXED, __HIP_MEMORY_SCOPE_AGENT); }
__device__ __forceinline__ unsigned xb_add(unsigned* p, unsigned v) { return __hip_atomic_fetch_add(p, v, __ATOMIC_RELAXED, __HIP_MEMORY_SCOPE_AGENT); }
__device__ __forceinline__ unsigned xb_xcc_id() { return (unsigned)__builtin_amdgcn_s_getreg((3 << 11) | 20) & 0xFu; }
#define XB_SPIN(cond, bar) do { unsigned _sp = 0; while (cond) { __builtin_amdgcn_s_sleep(1); \
    if ((++_sp & 255u) == 0u) { if (xb_ld(&(bar)[XB_TMO])) break; if (_sp > XB_SPIN_CAP) { atomicAdd(&(bar)[XB_TMO], 1u); break; } } } } while (0)

struct XcdBarrier {
    unsigned* bar; unsigned x;
    volatile LAS unsigned* st;
};

__device__ __forceinline__ XcdBarrier xcd_barrier_post(unsigned* bar, volatile LAS unsigned* st) {
    XcdBarrier b; b.bar = bar; b.x = xb_xcc_id(); b.st = st;
    if (threadIdx.x == 0) (void)xb_add(&bar[XB_XCNT(b.x)], 1u);
    return b;
}
__device__ __forceinline__ void xcd_barrier_complete(unsigned* bar, unsigned x, unsigned& nloc, unsigned& nx) {
    const unsigned G = gridDim.x * gridDim.y * gridDim.z;
    unsigned sum, cnt, mine, sp = 0u;
    for (;;) {
        sum = 0u; cnt = 0u; mine = 0u;
#pragma unroll
        for (unsigned j = 0; j < 16; ++j) { const unsigned c = xb_ld(&bar[XB_XCNT(j)]); sum += c; cnt += (c > 0u) ? 1u : 0u; mine = (j == x) ? c : mine; }
        if (sum == G) break;
        __builtin_amdgcn_s_sleep(1);
        if ((++sp & 255u) == 0u) { if (xb_ld(&bar[XB_TMO])) break; if (sp > XB_SPIN_CAP) { atomicAdd(&bar[XB_TMO], 1u); break; } }
    }
    nloc = mine > 0u ? mine : 1u; nx = cnt > 0u ? cnt : 1u;
}

__device__ __forceinline__ void xcd_barrier(const XcdBarrier& b) {
    asm volatile("s_waitcnt vmcnt(0)" ::: "memory");
    __syncthreads();
    if (threadIdx.x == 0) {
        unsigned* bar = b.bar;
        __builtin_amdgcn_s_waitcnt(0);
        unsigned nloc = b.st[0], nx = b.st[1];
        if (nloc == 0u) { xcd_barrier_complete(bar, b.x, nloc, nx); b.st[0] = nloc; b.st[1] = nx; }
        const unsigned old = xb_add(&bar[XB_XSUB(b.x)], 1u);
        const unsigned gen = old / nloc;
        if (old + 1u == (gen + 1u) * nloc) {
            __builtin_amdgcn_fence(__ATOMIC_RELEASE, "agent");
            asm volatile("s_waitcnt vmcnt(0)" ::: "memory");
            const unsigned og = xb_add(&bar[XB_TOP], 1u);
            const unsigned tg = og / nx;
            if (og + 1u == (tg + 1u) * nx) xb_add(&bar[XB_TOPGEN], 1u);
            else XB_SPIN(xb_ld(&bar[XB_TOPGEN]) == tg, bar);
            __builtin_amdgcn_fence(__ATOMIC_ACQUIRE, "agent");
            xb_add(&bar[XB_XGEN(b.x)], 1u);
            asm volatile("s_waitcnt vmcnt(0)" ::: "memory");
        } else {
            XB_SPIN(xb_ld(&bar[XB_XGEN(b.x)]) == gen, bar);
            __builtin_amdgcn_fence(__ATOMIC_ACQUIRE, "agent");
            asm volatile("s_waitcnt vmcnt(0)" ::: "memory");
        }
    }
    __syncthreads();
}


struct OneUnit { int pm;
    __device__ __forceinline__ bool next(int i, pg8::Unit& u) const { if (i != 0) return false; u.pm = pm; u.pn = 0; return true; }
    __device__ __forceinline__ void a_ready(const pg8::Unit&) const {}
    __device__ __forceinline__ void done(const pg8::Unit&) const {} };
__global__ void __launch_bounds__(NTHREADS) mega(Args a_unused) {
    KA a; a.p = (const __attribute__((address_space(4))) Args*)__builtin_amdgcn_kernarg_segment_ptr();
    extern __shared__ __attribute__((aligned(16))) unsigned char lds[];
    cg::grid_group grid = cg::this_grid();
    const int G = gridDim.x, bx = blockIdx.x;
    const int vcu = (G % 8 == 0) ? (bx % 8) * (G / 8) + bx / 8 : bx;
    bf16_t* const XN = (bf16_t*)(a->ws + WS_XN); bf16_t* const Z = (bf16_t*)(a->ws + WS_Z); bf16_t* const MIX = (bf16_t*)(a->ws + WS_MIX);
    bf16_t* const YG = (bf16_t*)(a->ws + WS_YG); bf16_t* const HID = (bf16_t*)(a->ws + WS_HID); bf16_t* const PP = (bf16_t*)(a->ws + WS_PP); bf16_t* const PBF = (bf16_t*)(a->ws + WS_PBF);
    float* const SSQA = (float*)(a->ws + WS_SSQA); float* const SSQB = (float*)(a->ws + WS_SSQB); float* const SSQC = (float*)(a->ws + WS_SSQC);
    PG8_LAS unsigned char* ldsl = (PG8_LAS unsigned char*)lds;
    volatile LAS unsigned* MISC = (volatile LAS unsigned*)(ldsl + LDS_BYTES - 64);
    if (threadIdx.x < 2) MISC[threadIdx.x] = 0u;
    __syncthreads();
    XcdBarrier xbar = xcd_barrier_post((unsigned*)a->ws, MISC);
    const int ph_lo = a->ph_lo, ph_hi = a->ph_hi;
    for (int ph = ph_lo; ph < ph_hi; ++ph) {
        asm volatile("" : "+s"(a.p));
        if (ph == 0) {
#ifndef NO_PRO
 prologue_phase(a, lds, bx, G);
#endif
 pcvt_rows(a, 0, bx * (MT / 256), MT / 256); __syncthreads(); }
        else {
            const int L = (ph - 1) / 6, kk6 = (ph - 1) % 6, k = kk6 < 2 ? kk6 : kk6 + 1;
            const bf16_t* wl = (const bf16_t*)(a->ws + WS_W) + (size_t)L * LW_ELEMS;
#ifndef NO_GOUT
            if (k == 0 || k == 4) {
                bf16_t* const XN2 = (bf16_t*)(a->ws + WS_XN2);
                const int npass = (k == 0 && bx >= G / 2) ? 2 : 1;
                for (int pass = 0; pass < npass; ++pass) {
                    pg8::Gemm g; pg8::EpiOut E; pg8::StaticOrder S;
                    if (k == 0 && pass == 0) { g = pg8::Gemm{L == 0 ? XN : XN2, wl + LW_IN, MT, INW, DM};   E = pg8::EpiOut{Z, INW, SSQA, 0, a->in[4] + L * 64, a->in[5] + L * 64}; S.init(g.M, g.N, G, bx); }
                    else if (k == 0)         { g = pg8::Gemm{PBF, wl + LW_PLE, MT, DM, PLEW}; E = pg8::EpiOut{PP, DM, nullptr, 0, nullptr, nullptr}; S.init(g.M, g.N, G / 2, bx - G / 2); }
                    else                     { g = pg8::Gemm{XN, wl + LW_FF1, MT, FFW, DM};  E = pg8::EpiOut{HID, FFW, SSQB, 2, nullptr, nullptr}; S.init(g.M, g.N, G, bx); }
                    pg8::gemm_phase<pg8::EpiOut, pg8::StaticOrder, true, true>(ldsl, g, S, E);
                }
            }
#endif
#ifndef NO_GRES
            if (k == 3 || k == 5 || k == 6) {
                pg8::Gemm g; pg8::EpiResid E;
                if (k == 3)      { g = pg8::Gemm{MIX, wl + LW_OUT, MT, DM, DM};  E = pg8::EpiResid{L == 0 ? a->in[0] : a->out, a->out, XN, SSQB, nullptr, nullptr, 0}; }
                else if (k == 5) { g = pg8::Gemm{HID, wl + LW_FF2, MT, DM, FFW}; E = pg8::EpiResid{a->out, a->out, XN, SSQC, nullptr, nullptr, 0}; }
                else             { g = pg8::Gemm{XN, wl + LW_GATE, MT, DM, DM};  E = pg8::EpiResid{a->out, a->out, (bf16_t*)(a->ws + WS_XN2), SSQA, SSQC, PP, 1}; }
                pg8::StaticOrder S; S.init(g.M, g.N, G, bx);
                pg8::gemm_phase<pg8::EpiResid, pg8::StaticOrder, true, true>(ldsl, g, S, E);
                if (k == 3 && L + 1 < DEPTH) pcvt_rows(a, L + 1, bx * (MT / 256), MT / 256);
            }
#endif
            if (k == 1) {
                float* stash = (float*)(a->ws + WS_STASH) + (size_t)bx * 64 * NTHREADS;
                unsigned* qbase = (unsigned*)(a->ws + 14336) + (size_t)L * 8 * 16;
                volatile LAS unsigned* qs = (volatile LAS unsigned*)(ldsl + LDS_BYTES - 32);
                const unsigned myq = xb_xcc_id() & 7u;
                const float lam_init = 0.8f - 0.6f * __expf(-0.3f * (float)L);
                float lam, smax_raw;
                { const int lane = threadIdx.x & 63;
                  const float v1 = wave_sum(a->in[6][L * 64 + lane] * a->in[7][L * 64 + lane]), v2 = wave_sum(a->in[8][L * 64 + lane] * a->in[9][L * 64 + lane]); lam = expf(v1) - expf(v2) + lam_init;
                  float gq = fabsf(a->in[4][L * 64 + lane]), gk = fabsf(a->in[5][L * 64 + lane]);
#pragma unroll
                  for (int o = 1; o < 64; o <<= 1) { gq = fmaxf(gq, __shfl_xor(gq, o)); gk = fmaxf(gk, __shfl_xor(gk, o)); }
                  smax_raw = 64.0f * gq * gk * 1.03f; }
                for (unsigned qo = 0; qo < 8u; ++qo) { const unsigned q = (myq + qo) & 7u;
                    bool pub = false;
                    for (;;) {
                        if (pub) asm volatile("s_waitcnt vmcnt(0)" ::: "memory");
                        if (threadIdx.x == 0) qs[0] = __hip_atomic_fetch_add(qbase + q * 16, 1u, __ATOMIC_RELAXED, __HIP_MEMORY_SCOPE_AGENT);
                        __syncthreads();
                        const unsigned idx = qs[0];
                        if (pub && threadIdx.x == 0) __hip_atomic_fetch_add(qbase + q * 16 + 1, 1u, __ATOMIC_RELAXED, __HIP_MEMORY_SCOPE_AGENT);
                        pub = (idx >= 32u && idx < 48u);
                        if (idx >= 112u && idx < 128u && threadIdx.x == 0) {
                            unsigned sp = 0;
                            while (__hip_atomic_load(qbase + q * 16 + 1, __ATOMIC_RELAXED, __HIP_MEMORY_SCOPE_AGENT) < 16u) { __builtin_amdgcn_s_sleep(8); if (++sp > (1u << 20)) break; }
                            __builtin_amdgcn_fence(__ATOMIC_ACQUIRE, "agent"); asm volatile("s_waitcnt vmcnt(0)" ::: "memory"); }
                        __syncthreads();
                        if (idx >= 256u) break;
                        if (idx >= 32u && idx < 48u) ssm_unit(a, L, (int)(q * 16u + (idx - 32u)), lds);
                        else if (idx < 112u) { const unsigned ja = idx < 32u ? idx : idx - 16u;
                            const int hh = ja < 64u ? 3 - (int)(ja & 1u) : 1 - (int)((ja - 64u) & 1u), qq = ja < 64u ? 31 - (int)(ja >> 1) : 15 - (int)((ja - 64u) >> 1);
                            att::attn_unit_k(a, L, (int)q, hh, qq, (char*)lds, stash, lam, lam_init, smax_raw); }
                        else if (idx < 128u) {
                            int kglu = SSW; asm volatile("" : "+s"(kglu));
                            pg8::Gemm g{YG, wl + LW_GLU, MT, SSW, kglu}; pg8::EpiGlu E{YG, a->in[24] + L * SSW, MIX};
                            OneUnit S; S.pm = (int)(q * 16u + (idx - 112u));
                            pg8::gemm_phase<pg8::EpiGlu, OneUnit, true, true>(ldsl, g, S, E);
                        }
                        else conv_unit(a, L, (int)(q * 128u + (idx - 128u)), lds);
                    } }
            }
        }
        if (ph + 1 < ph_hi)
        { if (ph_hi < 0) grid.sync(); else xcd_barrier(xbar); }
    }
}

#ifndef N_LAUNCH_MODE
#define N_LAUNCH_MODE 1
#endif
extern "C" void kernel_launch(void* const* d_in, const int* in_sizes, int n_in, void* d_out, int out_size, void* d_ws, size_t ws_size, hipStream_t stream) {
    static int grid = 0;
    if (grid == 0) {
        if (n_in != 32 || in_sizes[0] != MT * DM || out_size != MT * DM || ws_size < WS_END) {
            fprintf(stderr, "kernel_launch: shape mismatch n_in %d in0 %d out %d ws %zu (need %zu)\n", n_in, n_in > 0 ? in_sizes[0] : -1, out_size, ws_size, (size_t)WS_END); grid = -1; return; }
        int dev = 0, cus = 0, per_cu = 0;
        hipGetDevice(&dev); hipDeviceGetAttribute(&cus, hipDeviceAttributeMultiprocessorCount, dev);
        if (hipFuncSetAttribute((const void*)mega, hipFuncAttributeMaxDynamicSharedMemorySize, LDS_BYTES) != hipSuccess) { fprintf(stderr, "kernel_launch: hipFuncSetAttribute failed\n"); grid = -1; return; }
        hipOccupancyMaxActiveBlocksPerMultiprocessor(&per_cu, (const void*)mega, NTHREADS, LDS_BYTES);
        (void)hipGetLastError();
        grid = cus * (per_cu < 1 ? 1 : per_cu);
        if (grid != 256) { fprintf(stderr, "kernel_launch: grid %d (cus %d per_cu %d): this kernel is built for 256\n", grid, cus, per_cu); if (grid > 256) grid = 256; }
    }
    if (grid < 0) return;
    if (hipMemsetAsync(d_ws, 0, 16384, stream) != hipSuccess) { fprintf(stderr, "kernel_launch: memset failed\n"); return; }
    Args a{};
    for (int i = 0; i < 32; ++i) a.in[i] = (const float*)d_in[i];
    a.out = (float*)d_out; a.ws = (unsigned char*)d_ws;
    constexpr int NPH = 1 + 6 * DEPTH;
#if N_LAUNCH_MODE == 1
    a.ph_lo = 0; a.ph_hi = NPH;
    void* args[] = {&a};
    hipError_t e = hipLaunchCooperativeKernel((const void*)mega, dim3(grid), dim3(NTHREADS), args, LDS_BYTES, stream);
    if (e != hipSuccess) fprintf(stderr, "kernel_launch: cooperative launch failed: %s (grid %d)\n", hipGetErrorString(e), grid);
#else
    for (int ph = 0; ph < NPH; ++ph) { a.ph_lo = ph; a.ph_hi = ph + 1; hipLaunchKernelGGL(mega, dim3(grid), dim3(NTHREADS), LDS_BYTES, stream, a); }
#endif
}
```
